# Optimizing an MI355X kernel written in HIP

```python
import math
import jax, jax.numpy as jnp
from jax import lax
import numpy as np

D_MODEL = 1024
BATCH = 8
SEQ = 4096
DEPTH = 1

LRU_HEADS = 8
LRU_BLOCK = D_MODEL // 8
D_LRU = LRU_HEADS * LRU_BLOCK
CONV_GROUPS = 4
D_CONV = CONV_GROUPS * (D_MODEL // 8)
D_MIX = D_LRU + D_CONV
D_IN = 2 * D_LRU + 3 * D_CONV
IN_SPLITS = (D_LRU, 2 * D_LRU, 2 * D_LRU + D_CONV, 2 * D_LRU + 2 * D_CONV)
LRU_CONV_W = 4
LRU_PADS = ((LRU_CONV_W - 1, 0), (0, LRU_CONV_W - 1))
LRU_C = 8.0
SHORT_CONV_W = 3

PEER_HEADS = 8
PEER_QDIM = 256
PEER_HALF = PEER_QDIM // 2
N_KEYS = 128
N_EXPERTS = N_KEYS * N_KEYS
PEER_TOPK = 16
PEER_CHUNK = 128

LN_EPS = 1e-5
RMS_EPS = 1e-6
ALPHA = (2.0 * DEPTH) ** 0.25
BETA = (8.0 * DEPTH) ** -0.25

kernel_name = "hymba_griffin_shortconv_peer_encoder_block"


def layer_norm(x, g, b):
    xf = x.astype(jnp.float32)
    mu = jnp.mean(xf, axis=-1, keepdims=True)
    var = jnp.mean(jnp.square(xf - mu), axis=-1, keepdims=True)
    y = (xf - mu) * lax.rsqrt(var + LN_EPS) * g.astype(jnp.float32) + b.astype(jnp.float32)
    return y.astype(x.dtype)


def rms_norm(x, g):
    xf = x.astype(jnp.float32)
    y = xf * lax.rsqrt(jnp.mean(jnp.square(xf), axis=-1, keepdims=True) + RMS_EPS) * g.astype(jnp.float32)
    return y.astype(x.dtype)


def depthwise_conv(x, w, pad):
    c = x.shape[-1]
    return lax.conv_general_dilated(
        x, w[:, None, :].astype(x.dtype), window_strides=(1,), padding=[pad],
        dimension_numbers=("NWC", "WIO", "NWC"), feature_group_count=c)


def block_diag_linear(x, w, b):
    bsz, s, d = x.shape
    xh = x.reshape(bsz, s, LRU_HEADS, LRU_BLOCK)
    y = jnp.einsum("bshi,hij->bshj", xh, w.astype(x.dtype)).reshape(bsz, s, d)
    return y + b.astype(x.dtype)


def _linear_recurrence_combine(left, right):
    a_l, b_l = left
    a_r, b_r = right
    return a_l * a_r, a_r * b_l + b_r


def rg_lru(xc, w_a, b_a, w_x, b_x, lam, reverse):
    r = jax.nn.sigmoid(block_diag_linear(xc, w_a, b_a).astype(jnp.float32))
    i = jax.nn.sigmoid(block_diag_linear(xc, w_x, b_x).astype(jnp.float32))
    log_a = -LRU_C * r * jax.nn.softplus(-lam.astype(jnp.float32))
    a = jnp.exp(log_a)
    u = jnp.sqrt(-jnp.expm1(2.0 * log_a)) * (i * xc.astype(jnp.float32))
    if reverse:
        a = jnp.flip(a, axis=1)
        u = jnp.flip(u, axis=1)
    _, h = lax.associative_scan(_linear_recurrence_combine, (a, u), axis=1)
    if reverse:
        h = jnp.flip(h, axis=1)
    return h.astype(xc.dtype)


def peer(x, w_q, k1, k2, u_tab, v_tab):
    bsz, s, d = x.shape
    t = bsz * s
    xt = x.reshape(t, d)
    q = (xt @ w_q.astype(x.dtype)).reshape(t, PEER_HEADS, 2, PEER_HALF)
    s1 = jnp.einsum("thd,kd->thk", q[:, :, 0], k1.astype(x.dtype)).astype(jnp.float32)
    s2 = jnp.einsum("thd,kd->thk", q[:, :, 1], k2.astype(x.dtype)).astype(jnp.float32)
    v1, i1 = lax.top_k(s1, PEER_TOPK)
    v2, i2 = lax.top_k(s2, PEER_TOPK)
    cand_s = (v1[..., :, None] + v2[..., None, :]).reshape(t, PEER_HEADS, PEER_TOPK * PEER_TOPK)
    cand_i = (i1[..., :, None] * N_KEYS + i2[..., None, :]).reshape(t, PEER_HEADS, PEER_TOPK * PEER_TOPK)
    top_s, pos = lax.top_k(cand_s, PEER_TOPK)
    idx = jnp.take_along_axis(cand_i, pos, axis=-1)
    g = jax.nn.softmax(top_s, axis=-1)

    n_blocks = t // PEER_CHUNK
    e_per_tok = PEER_HEADS * PEER_TOPK
    xb_all = xt.reshape(n_blocks, PEER_CHUNK, d)
    ib_all = idx.reshape(n_blocks, PEER_CHUNK, e_per_tok)
    gb_all = g.reshape(n_blocks, PEER_CHUNK, e_per_tok).astype(x.dtype)

    def expert_block(args):
        xb, ib, gb = args
        u = u_tab[ib].astype(x.dtype)
        act = jax.nn.gelu(jnp.einsum("cd,ced->ce", xb, u), approximate=False)
        v = v_tab[ib].astype(x.dtype)
        return jnp.einsum("ce,ced->cd", gb * act, v)

    y = lax.map(expert_block, (xb_all, ib_all, gb_all))
    return y.reshape(bsz, s, d)


def setup_inputs(seed: int = 0) -> dict:
    key = jax.random.key(seed)
    ks = jax.random.split(key, 28)
    f32 = jnp.float32
    L = DEPTH

    def nrm(k, shape, scale):
        return jax.random.normal(k, shape, f32) * scale

    a0 = jax.random.uniform(ks[10], (L, 2, D_LRU), f32, minval=0.9, maxval=0.999)
    p = a0 ** (1.0 / LRU_C)
    lam = jnp.log(p) - jnp.log1p(-p)

    return {
        "x": nrm(ks[0], (BATCH, SEQ, D_MODEL), 1.0),
        "ln_emb_g": 1.0 + nrm(ks[1], (D_MODEL,), 0.02),
        "ln_emb_b": nrm(ks[2], (D_MODEL,), 0.02),
        "w_in": nrm(ks[3], (L, D_MODEL, D_IN), D_MODEL ** -0.5),
        "lru_conv_w": nrm(ks[4], (L, 2, LRU_CONV_W, D_LRU), LRU_CONV_W ** -0.5),
        "lru_conv_b": nrm(ks[5], (L, 2, D_LRU), 0.01),
        "lru_wa": nrm(ks[6], (L, 2, LRU_HEADS, LRU_BLOCK, LRU_BLOCK), LRU_BLOCK ** -0.5),
        "lru_ba": nrm(ks[7], (L, 2, D_LRU), 0.01),
        "lru_wx": nrm(ks[8], (L, 2, LRU_HEADS, LRU_BLOCK, LRU_BLOCK), LRU_BLOCK ** -0.5),
        "lru_bx": nrm(ks[9], (L, 2, D_LRU), 0.01),
        "lru_lambda": lam,
        "conv_w": nrm(ks[11], (L, SHORT_CONV_W, D_CONV), SHORT_CONV_W ** -0.5),
        "norm_lru_g": 1.0 + nrm(ks[12], (L, D_LRU), 0.02),
        "norm_conv_g": 1.0 + nrm(ks[13], (L, D_CONV), 0.02),
        "w_out": nrm(ks[14], (L, D_MIX, D_MODEL), BETA * D_MIX ** -0.5),
        "ln1_g": 1.0 + nrm(ks[15], (L, D_MODEL), 0.02),
        "ln1_b": nrm(ks[16], (L, D_MODEL), 0.02),
        "peer_wq": nrm(ks[17], (L, D_MODEL, PEER_HEADS * PEER_QDIM), D_MODEL ** -0.5),
        "peer_k1": nrm(ks[18], (L, N_KEYS, PEER_HALF), PEER_HALF ** -0.5),
        "peer_k2": nrm(ks[19], (L, N_KEYS, PEER_HALF), PEER_HALF ** -0.5),
        "peer_u": nrm(ks[20], (L, N_EXPERTS, D_MODEL), D_MODEL ** -0.5),
        "peer_v": nrm(ks[21], (L, N_EXPERTS, D_MODEL), BETA),
        "ln2_g": 1.0 + nrm(ks[22], (L, D_MODEL), 0.02),
        "ln2_b": nrm(ks[23], (L, D_MODEL), 0.02),
    }


def reference(x, ln_emb_g, ln_emb_b, w_in, lru_conv_w, lru_conv_b, lru_wa, lru_ba, lru_wx, lru_bx,
              lru_lambda, conv_w, norm_lru_g, norm_conv_g, w_out, ln1_g, ln1_b,
              peer_wq, peer_k1, peer_k2, peer_u, peer_v, ln2_g, ln2_b):
    h = layer_norm(x, ln_emb_g, ln_emb_b)
    for l in range(DEPTH):
        z = h @ w_in[l].astype(h.dtype)
        xr, gate, cb, cc, cx = jnp.split(z, IN_SPLITS, axis=-1)
        lru = None
        for d, pad in enumerate(LRU_PADS):
            xc = depthwise_conv(xr, lru_conv_w[l, d], pad) + lru_conv_b[l, d].astype(xr.dtype)
            hd = rg_lru(xc, lru_wa[l, d], lru_ba[l, d], lru_wx[l, d], lru_bx[l, d],
                        lru_lambda[l, d], reverse=(d == 1))
            lru = hd if lru is None else lru + hd
        y_lru = jax.nn.gelu(gate) * lru
        y_conv = cb * depthwise_conv(cc * cx, conv_w[l], (1, 1))
        mix = jnp.concatenate([rms_norm(y_lru, norm_lru_g[l]),
                               rms_norm(y_conv, norm_conv_g[l])], axis=-1)
        h = layer_norm(ALPHA * h + mix @ w_out[l].astype(h.dtype), ln1_g[l], ln1_b[l])
        f = peer(h, peer_wq[l], peer_k1[l], peer_k2[l], peer_u[l], peer_v[l])
        h = layer_norm(ALPHA * h + f, ln2_g[l], ln2_b[l])
    return h
```

```cpp
#include <hip/hip_runtime.h>
#include <hip/hip_cooperative_groups.h>
#include <cstdio>
#include <cstdint>
#include <cmath>
#ifndef ONE_LAUNCH
#define ONE_LAUNCH 0
#endif
namespace pg8 {
#define PG8_LAS __attribute__((address_space(3)))
typedef unsigned short bf16_t;
typedef short bf16x8 __attribute__((ext_vector_type(8)));
typedef float f32x4 __attribute__((ext_vector_type(4)));
typedef unsigned u32x4 __attribute__((ext_vector_type(4)));
constexpr int BM = 256, BK = 64, HALF = 128, HTB = HALF * BK * 2  , STAGE_BYTES = 8 * HTB, NXCD = 8, WGM = 8;

__host__ __device__ __forceinline__ int lds_byte(int r, int c) { const int st = (r >> 4) * 2 + (c >> 5), rr = r & 15, cc = c & 31, ob = rr * 64 + cc * 2; return st * 1024 + (ob ^ (((ob >> 9) & 1) << 5)); }
__host__ __device__ __forceinline__ void stage_rc(int b, int& R, int& C) { const int st = b / 1024, sb = b % 1024, swz = sb ^ (((sb >> 9) & 1) << 5); R = (st >> 1) * 16 + swz / 64; C = (st & 1) * 32 + (swz % 64) / 2; }
__host__ __device__ __forceinline__ int perm32(int rho) { const int n = rho >> 4, i = rho & 15; return 8 * (i >> 2) + 4 * n + (i & 3); }

struct Unit { int pm, pn; };
struct Gemm { const bf16_t* A; const bf16_t* Bt; int M, N, K; };

struct StaticOrder {
    int nM, nN, nwg, G, c;
    __host__ __device__ void init(int M, int N, int G_, int c_) { nM = M / BM; nN = N / BM; nwg = nM * nN; G = G_; c = c_; }
    __host__ __device__ bool next(int i, Unit& u) const {
        const long L = (long)i * G + c; if (L >= nwg) return false;
        int wgid = (int)L; { const int q = nwg / NXCD, r = nwg % NXCD, xcd = wgid % NXCD, off = wgid / NXCD; wgid = (xcd < r ? xcd * (q + 1) : r * (q + 1) + (xcd - r) * q) + off; }
        const int nig = WGM * nN, gid = wgid / nig, fm = gid * WGM, gsz = (nM - fm) < WGM ? (nM - fm) : WGM;
        u.pm = fm + ((wgid % nig) % gsz); u.pn = (wgid % nig) / gsz; return true;
    }
    __device__ __forceinline__ void a_ready(const Unit&) const {}
    __device__ __forceinline__ void done(const Unit&) const {}
};

__device__ __forceinline__ unsigned cvt_pk_bf16(float lo, float hi) { unsigned r; asm volatile("v_cvt_pk_bf16_f32 %0, %1, %2" : "=v"(r) : "v"(lo), "v"(hi)); return r; }
typedef float f32x2 __attribute__((ext_vector_type(2)));
__device__ __forceinline__ f32x2 gelu_pk(f32x2 v) {
    const f32x2 av = __builtin_elementwise_abs(v), d = av * 0.2316418882f + 1.0f;
    f32x2 t; t.x = __builtin_amdgcn_rcpf(d.x); t.y = __builtin_amdgcn_rcpf(d.y);
    f32x2 q = t * 0.5307027145f + (-0.7265760135f); q = q * t + 0.7107068705f; q = q * t + (-0.142248368f); q = q * t + 0.127414796f; q = q * t;
    const f32x2 s = (v * v) * (-0.72134752044f);
    f32x2 e; e.x = __builtin_amdgcn_exp2f(s.x); e.y = __builtin_amdgcn_exp2f(s.y);
    const f32x2 m = v * (q * e), r = v - m;
    f32x2 o; o.x = v.x < 0.f ? m.x : r.x; o.y = v.y < 0.f ? m.y : r.y; return o;
}

template <int ACT  > struct EpiBf16 {
    static constexpr bool PERM = true, AFTER_DRAIN = false; static_assert(ACT == 0 || ACT == 1, "EpiBf16: ACT is 0 (none) or 1 (gelu_pk)");
    bf16_t* O; int ldc; const float* bias; int split_cols; size_t split_stride; float scale0;
    __device__ __forceinline__ void operator()(const f32x4 (&acc)[2][2][4][2], const Unit& u, int wr, int wc, int fr, int fq) const {
        const int row0 = u.pm * BM + wr * 64 + fr; int colt = u.pn * BM; bf16_t* base = O;
        float sc = 1.f; if (split_cols) { const int t = colt / split_cols; base += (size_t)t * split_stride; colt -= t * split_cols; if (t == 0) sc = scale0; }
        const int col0 = colt + wc * 32 + 8 * fq, bcol0 = u.pn * BM + wc * 32 + 8 * fq;
        f32x4 bv[2][2];
#pragma unroll
        for (int bj = 0; bj < 2; ++bj)
#pragma unroll
            for (int n = 0; n < 2; ++n) bv[bj][n] = bias ? *(const f32x4*)(bias + bcol0 + bj * HALF + 4 * n) : (f32x4){0.f, 0.f, 0.f, 0.f};
#pragma unroll
        for (int ai = 0; ai < 2; ++ai)
#pragma unroll
            for (int m = 0; m < 4; ++m) { bf16_t* rowp = base + (size_t)(row0 + ai * HALF + m * 16) * ldc + col0;
#pragma unroll
                for (int bj = 0; bj < 2; ++bj) { f32x4 v0 = acc[ai][bj][m][0] + bv[bj][0], v1 = acc[ai][bj][m][1] + bv[bj][1];
                    if (ACT == 1) { f32x2 a = gelu_pk((f32x2){v0[0], v0[1]}), b = gelu_pk((f32x2){v0[2], v0[3]}), c = gelu_pk((f32x2){v1[0], v1[1]}), d = gelu_pk((f32x2){v1[2], v1[3]});
                        v0 = (f32x4){a.x, a.y, b.x, b.y}; v1 = (f32x4){c.x, c.y, d.x, d.y}; }
                    v0 = v0 * sc; v1 = v1 * sc; u32x4 w; w.x = cvt_pk_bf16(v0[0], v0[1]); w.y = cvt_pk_bf16(v0[2], v0[3]); w.z = cvt_pk_bf16(v1[0], v1[1]); w.w = cvt_pk_bf16(v1[2], v1[3]);
                    *(u32x4*)(rowp + bj * HALF) = w; } }
    }
};
template <class Epi, class Sched, bool ALIGN_EPI = false, bool SP2 = false>
__device__ __forceinline__ void gemm_phase(PG8_LAS unsigned char* lds, const Gemm g, const Sched& S, const Epi& E) {
    const int tid = threadIdx.x, wid = __builtin_amdgcn_readfirstlane(tid >> 6), lane = tid & 63, wr = wid >> 2, wc = wid & 3, fr = lane & 15, fq = lane >> 4;
    const int K = g.K, nt = K / BK;
    unsigned voffA[2], voffB[2];
#pragma unroll
    for (int i = 0; i < 2; ++i) { int R, C; stage_rc(tid * 16 + i * 8192, R, C); const int Rb = Epi::PERM ? ((R & ~31) + perm32(R & 31)) : R;
        voffA[i] = (unsigned)(R * K + C) * 2u; voffB[i] = (unsigned)(Rb * K + C) * 2u; }
    const size_t kstep = (size_t)(BK * 2);
    const size_t hstep = (size_t)HALF * K * 2;
    const size_t tstep = 2 * hstep;
    const unsigned ldsw = (unsigned)wid * 1024u;
    const int aoff = lds_byte(wr * 64 + fr, fq * 8), boff = lds_byte(wc * 32 + fr, fq * 8);
#define PG8_SA(b, h) (((b) * 2 + (h)) * HTB)
#define PG8_SB(b, h) ((4 + (b) * 2 + (h)) * HTB)
#define PG8_STAGE(bufoff, gbase, voff) do { _Pragma("unroll") for (int _i = 0; _i < 2; ++_i) \
        __builtin_amdgcn_global_load_lds((const unsigned*)((const char*)(gbase) + (voff)[_i]), (PG8_LAS unsigned*)(lds + (bufoff) + ldsw + _i * 8192), 16, 0, 0); } while (0)
#define PG8_LDA(dst, b, h) do { _Pragma("unroll") for (int m = 0; m < 4; ++m) _Pragma("unroll") for (int k = 0; k < 2; ++k) dst[m][k] = *(const PG8_LAS bf16x8*)(lds + PG8_SA(b, h) + aoff + m * 2048 + k * 1024); } while (0)
#define PG8_LDB(dst, b, h) do { _Pragma("unroll") for (int n = 0; n < 2; ++n) _Pragma("unroll") for (int k = 0; k < 2; ++k) dst[n][k] = *(const PG8_LAS bf16x8*)(lds + PG8_SB(b, h) + boff + n * 2048 + k * 1024); } while (0)
#define PG8_MMA(ai, bj, At, Bt) do { __builtin_amdgcn_s_setprio(1); _Pragma("unroll") for (int m = 0; m < 4; ++m) _Pragma("unroll") for (int n = 0; n < 2; ++n) _Pragma("unroll") for (int k = 0; k < 2; ++k) \
        acc[ai][bj][m][n] = __builtin_amdgcn_mfma_f32_16x16x32_bf16(Bt[n][k], At[m][k], acc[ai][bj][m][n], 0, 0, 0); __builtin_amdgcn_s_setprio(0); } while (0)
#define PG8_WAIT_V(n) asm volatile("s_waitcnt vmcnt(" #n ")" ::: "memory")
#define PG8_WAIT_L(n) asm volatile("s_waitcnt lgkmcnt(" #n ")" ::: "memory")
#define PG8_BAR __builtin_amdgcn_s_barrier()
#define PG8_SCHED __builtin_amdgcn_sched_barrier(0)
    Unit cur, nxt; int ui = 0;
    if (!S.next(0, cur)) return;
    f32x4 acc[2][2][4][2];
#pragma unroll
    for (int a = 0; a < 2; ++a)
#pragma unroll
        for (int b = 0; b < 2; ++b)
#pragma unroll
            for (int m = 0; m < 4; ++m)
#pragma unroll
                for (int n = 0; n < 2; ++n) acc[a][b][m][n] = (f32x4){0.f, 0.f, 0.f, 0.f};
    bf16x8 At[4][2], B0[2][2], B1[2][2];
    const char* cA = (const char*)g.A + (size_t)cur.pm * tstep; const char* cB = (const char*)g.Bt + (size_t)cur.pn * tstep;
    S.a_ready(cur);
    if constexpr (SP2) {
        PG8_STAGE(PG8_SB(0, 0), cB, voffB); PG8_STAGE(PG8_SB(0, 1), cB + hstep, voffB); PG8_STAGE(PG8_SA(0, 0), cA, voffA); PG8_STAGE(PG8_SA(0, 1), cA + hstep, voffA);
        if (wr == 1) PG8_BAR;
        PG8_WAIT_V(2); PG8_BAR;
        PG8_STAGE(PG8_SB(1, 0), cB + kstep, voffB); PG8_STAGE(PG8_SA(1, 0), cA + kstep, voffA); PG8_STAGE(PG8_SB(1, 1), cB + hstep + kstep, voffB);
        PG8_WAIT_V(6); PG8_BAR;
    } else {
        PG8_STAGE(PG8_SB(0, 0), cB, voffB); PG8_STAGE(PG8_SA(0, 0), cA, voffA); PG8_STAGE(PG8_SB(0, 1), cB + hstep, voffB); PG8_STAGE(PG8_SA(0, 1), cA + hstep, voffA);
        if (wr == 1) PG8_BAR;
        PG8_WAIT_V(4); PG8_BAR;
        PG8_STAGE(PG8_SB(1, 0), cB + kstep, voffB); PG8_STAGE(PG8_SA(1, 0), cA + kstep, voffA); PG8_STAGE(PG8_SB(1, 1), cB + hstep + kstep, voffB);
        PG8_WAIT_V(6); PG8_BAR;
    }
    for (;;) {
        const bool has_next = S.next(ui + 1, nxt);
        const char* nA = has_next ? (const char*)g.A + (size_t)nxt.pm * tstep : cA; const char* nB = has_next ? (const char*)g.Bt + (size_t)nxt.pn * tstep : cB;
        for (int t = 0; t < nt; t += 2) {
            const bool last = (t == nt - 2);
            const char* a1 = cA + (size_t)(t + 1) * kstep;
            const char* a2 = last ? nA : cA + (size_t)(t + 2) * kstep; const char* b2 = last ? nB : cB + (size_t)(t + 2) * kstep;
            const char* a3 = a2 + kstep; const char* b3 = b2 + kstep;
            if (last && has_next) S.a_ready(nxt);
            if constexpr (SP2) {
            PG8_LDB(B0, 0, 0); PG8_LDB(B1, 0, 1); PG8_SCHED; PG8_LDA(At, 0, 0); PG8_STAGE(PG8_SA(1, 1), a1 + hstep, voffA);
            PG8_WAIT_V(8); PG8_WAIT_L(0); PG8_BAR; PG8_MMA(0, 0, At, B0); PG8_MMA(0, 1, At, B1); PG8_BAR; PG8_SCHED;
            PG8_LDA(At, 0, 1); PG8_STAGE(PG8_SB(0, 0), b2, voffB); PG8_STAGE(PG8_SB(0, 1), b2 + hstep, voffB); PG8_STAGE(PG8_SA(0, 0), a2, voffA);
            PG8_WAIT_V(8); PG8_WAIT_L(0); PG8_BAR; PG8_MMA(1, 0, At, B0); PG8_MMA(1, 1, At, B1); PG8_BAR; PG8_SCHED;
            PG8_LDB(B0, 1, 0); PG8_LDB(B1, 1, 1); PG8_SCHED; PG8_LDA(At, 1, 0); PG8_STAGE(PG8_SA(0, 1), a2 + hstep, voffA);
            PG8_WAIT_V(8); PG8_WAIT_L(0); PG8_BAR; PG8_MMA(0, 0, At, B0); PG8_MMA(0, 1, At, B1); PG8_BAR; PG8_SCHED;
            PG8_LDA(At, 1, 1); PG8_STAGE(PG8_SB(1, 0), b3, voffB); PG8_STAGE(PG8_SB(1, 1), b3 + hstep, voffB); PG8_STAGE(PG8_SA(1, 0), a3, voffA);
            PG8_WAIT_V(8); PG8_WAIT_L(0); PG8_BAR; PG8_MMA(1, 0, At, B0); PG8_MMA(1, 1, At, B1); PG8_BAR; PG8_SCHED;
            } else {
            PG8_LDB(B0, 0, 0); PG8_SCHED; PG8_LDA(At, 0, 0); PG8_STAGE(PG8_SA(1, 1), a1 + hstep, voffA);
            PG8_WAIT_L(8); PG8_BAR; PG8_WAIT_L(0); PG8_MMA(0, 0, At, B0); PG8_BAR; PG8_SCHED;
            PG8_LDB(B1, 0, 1); PG8_STAGE(PG8_SB(0, 0), b2, voffB);
            PG8_BAR; PG8_WAIT_L(0); PG8_MMA(0, 1, At, B1); PG8_BAR;
            PG8_LDA(At, 0, 1); PG8_STAGE(PG8_SA(0, 0), a2, voffA);
            PG8_BAR; PG8_WAIT_L(0); PG8_MMA(1, 0, At, B0); PG8_BAR; PG8_SCHED;
            PG8_STAGE(PG8_SB(0, 1), b2 + hstep, voffB);
            PG8_WAIT_V(6); PG8_BAR; PG8_MMA(1, 1, At, B1); PG8_BAR;
            PG8_LDB(B0, 1, 0); PG8_SCHED; PG8_LDA(At, 1, 0); PG8_STAGE(PG8_SA(0, 1), a2 + hstep, voffA);
            PG8_WAIT_L(8); PG8_BAR; PG8_WAIT_L(0); PG8_MMA(0, 0, At, B0); PG8_BAR; PG8_SCHED;
            PG8_LDB(B1, 1, 1); PG8_STAGE(PG8_SB(1, 0), b3, voffB);
            PG8_BAR; PG8_WAIT_L(0); PG8_MMA(0, 1, At, B1); PG8_BAR;
            PG8_LDA(At, 1, 1); PG8_STAGE(PG8_SA(1, 0), a3, voffA);
            PG8_BAR; PG8_WAIT_L(0); PG8_MMA(1, 0, At, B0); PG8_BAR; PG8_SCHED;
            PG8_STAGE(PG8_SB(1, 1), b3 + hstep, voffB);
            PG8_WAIT_V(6); PG8_BAR; PG8_MMA(1, 1, At, B1); PG8_BAR;
            }
        }
        if constexpr (ALIGN_EPI) { if (wr == 0) PG8_BAR; }
        if constexpr (!Epi::AFTER_DRAIN) { E(acc, cur, wr, wc, fr, fq); S.done(cur); }
        if (!has_next) break;
#pragma unroll
        for (int a = 0; a < 2; ++a)
#pragma unroll
            for (int b = 0; b < 2; ++b)
#pragma unroll
                for (int m = 0; m < 4; ++m)
#pragma unroll
                    for (int n = 0; n < 2; ++n) acc[a][b][m][n] = (f32x4){0.f, 0.f, 0.f, 0.f};
        cur = nxt; cA = nA; cB = nB; ++ui;
        if constexpr (ALIGN_EPI) { if (wr == 1) PG8_BAR; }
    }
    PG8_WAIT_V(0);
    if constexpr (!ALIGN_EPI) { if (wr == 0) PG8_BAR; }
    PG8_BAR;
    if constexpr (Epi::AFTER_DRAIN) { E.fused(acc, cur, wr, wc, fr, fq, lds, wid, lane); S.done(cur); }
#undef PG8_SA
#undef PG8_SB
#undef PG8_STAGE
#undef PG8_LDA
#undef PG8_LDB
#undef PG8_MMA
#undef PG8_WAIT_V
#undef PG8_WAIT_L
#undef PG8_BAR
#undef PG8_SCHED
}
}
#define GAS __attribute__((address_space(1)))
#define LAS __attribute__((address_space(3)))
typedef unsigned short bf16;
typedef unsigned v4u __attribute__((ext_vector_type(4)));
typedef float f32x4 __attribute__((ext_vector_type(4)));
typedef short bf16x8 __attribute__((ext_vector_type(8)));
typedef GAS unsigned gu32;
typedef GAS unsigned long long gu64;
#define RLX_AGENT __ATOMIC_RELAXED, __HIP_MEMORY_SCOPE_AGENT
#define LDS_WAIT() asm volatile("s_waitcnt lgkmcnt(0)" ::: "memory")
#define VM_WAIT() asm volatile("s_waitcnt vmcnt(0)" ::: "memory")
__device__ __forceinline__ unsigned long long rt() { return __builtin_amdgcn_s_memrealtime(); }
__device__ __forceinline__ unsigned f2bf(float f) { unsigned u = __builtin_bit_cast(unsigned, f); return (u + 0x7fffu + ((u >> 16) & 1u)) >> 16; }
__device__ __forceinline__ unsigned pk2(float lo, float hi) { return f2bf(lo) | (f2bf(hi) << 16); }

#define XB_TMO      128
#define XB_XCNT(j)  (256  + 64 * (j))
#define XB_XSUB(j)  (1280 + 64 * (j))
#define XB_XGEN(j)  (2304 + 64 * (j))
#define XB_TOP      3328
#define XB_TOPGEN   3392
#define XCD_BAR_WORDS 3456
#define XB_SPIN_CAP (1u << 18)

__device__ __forceinline__ unsigned xb_ld(unsigned* p)              { return __hip_atomic_load(p, __ATOMIC_RELAXED, __HIP_MEMORY_SCOPE_AGENT); }
__device__ __forceinline__ unsigned xb_add(unsigned* p, unsigned v) { return __hip_atomic_fetch_add(p, v, __ATOMIC_RELAXED, __HIP_MEMORY_SCOPE_AGENT); }
__device__ __forceinline__ unsigned xb_xcc_id() { return (unsigned)__builtin_amdgcn_s_getreg((3 << 11) | 20) & 0xFu; }
#define XB_SPIN(cond, bar) do { unsigned _sp = 0; while (cond) { __builtin_amdgcn_s_sleep(1); \
    if ((++_sp & 255u) == 0u) { if (xb_ld(&(bar)[XB_TMO])) break; if (_sp > XB_SPIN_CAP) { atomicAdd(&(bar)[XB_TMO], 1u); break; } } } } while (0)

struct XcdBarrier {
    unsigned* bar; unsigned x;
    volatile LAS unsigned* st;
};

__device__ __forceinline__ XcdBarrier xcd_barrier_post(unsigned* bar, volatile LAS unsigned* st) {
    XcdBarrier b; b.bar = bar; b.x = xb_xcc_id(); b.st = st;
    if (threadIdx.x == 0) (void)xb_add(&bar[XB_XCNT(b.x)], 1u);
    return b;
}
__device__ __forceinline__ void xcd_barrier_complete(unsigned* bar, unsigned x, unsigned& nloc, unsigned& nx) {
    const unsigned G = gridDim.x * gridDim.y * gridDim.z;
    unsigned sum, cnt, mine, sp = 0u;
    for (;;) {
        sum = 0u; cnt = 0u; mine = 0u;
#pragma unroll
        for (unsigned j = 0; j < 16; ++j) { const unsigned c = xb_ld(&bar[XB_XCNT(j)]); sum += c; cnt += (c > 0u) ? 1u : 0u; mine = (j == x) ? c : mine; }
        if (sum == G) break;
        __builtin_amdgcn_s_sleep(1);
        if ((++sp & 255u) == 0u) { if (xb_ld(&bar[XB_TMO])) break; if (sp > XB_SPIN_CAP) { atomicAdd(&bar[XB_TMO], 1u); break; } }
    }
    nloc = mine > 0u ? mine : 1u; nx = cnt > 0u ? cnt : 1u;
}

__device__ __forceinline__ void xcd_barrier(const XcdBarrier& b) {
    asm volatile("s_waitcnt vmcnt(0)" ::: "memory");
    __syncthreads();
    if (threadIdx.x == 0) {
        unsigned* bar = b.bar;
        __builtin_amdgcn_s_waitcnt(0);
        unsigned nloc = b.st[0], nx = b.st[1];
        if (nloc == 0u) { xcd_barrier_complete(bar, b.x, nloc, nx); b.st[0] = nloc; b.st[1] = nx; }
        const unsigned old = xb_add(&bar[XB_XSUB(b.x)], 1u);
        const unsigned gen = old / nloc;
        if (old + 1u == (gen + 1u) * nloc) {
            __builtin_amdgcn_fence(__ATOMIC_RELEASE, "agent");
            asm volatile("s_waitcnt vmcnt(0)" ::: "memory");
            const unsigned og = xb_add(&bar[XB_TOP], 1u);
            const unsigned tg = og / nx;
            if (og + 1u == (tg + 1u) * nx) xb_add(&bar[XB_TOPGEN], 1u);
            else XB_SPIN(xb_ld(&bar[XB_TOPGEN]) == tg, bar);
            __builtin_amdgcn_fence(__ATOMIC_ACQUIRE, "agent");
            xb_add(&bar[XB_XGEN(b.x)], 1u);
            asm volatile("s_waitcnt vmcnt(0)" ::: "memory");
        } else {
            XB_SPIN(xb_ld(&bar[XB_XGEN(b.x)]) == gen, bar);
            __builtin_amdgcn_fence(__ATOMIC_ACQUIRE, "agent");
            asm volatile("s_waitcnt vmcnt(0)" ::: "memory");
        }
    }
    __syncthreads();
}

#if ONE_LAUNCH
#define GRID_SYNC() cooperative_groups::this_grid().sync()
#else
#define GRID_SYNC() do {} while (0)
#endif

constexpr int BATCH = 8, SEQ = 4096, DM = 1024, T = BATCH * SEQ;
constexpr int D_IN = 3584, D_MIX = 1536, D_Q = 2048;
constexpr int LCH = 64, NCHUNK = SEQ / LCH;
constexpr float LN_EPS = 1e-5f, RMS_EPS = 1e-6f;
constexpr float ALPHA = 1.189207115002721f;
constexpr int NWAVES = 8, NTHREADS = 512;

constexpr size_t MiB = 1u << 20;
constexpr size_t WS_CTL = 0, CTL_ZERO_BYTES = 1 * MiB;
constexpr size_t WS_WIN = 1 * MiB;
constexpr size_t WS_WOUT = 8 * MiB;
constexpr size_t WS_WQ = 11 * MiB;
constexpr size_t WS_GW = 15 * MiB;
constexpr size_t WS_K1 = 16 * MiB;
constexpr size_t WS_K2 = 16 * MiB + 64 * 1024;
constexpr size_t WS_CARRY = 18 * MiB;
constexpr size_t WS_SUMM = 24 * MiB;
constexpr size_t WS_H0 = 32 * MiB;
constexpr size_t WS_H1 = 32 * MiB;
constexpr size_t WS_XR = 96 * MiB;
constexpr size_t WS_PRE1 = 96 * MiB;
constexpr size_t WS_GATE = 160 * MiB;
constexpr size_t WS_CCX = 224 * MiB;
constexpr size_t WS_U16 = 224 * MiB;
constexpr size_t WS_V16 = 256 * MiB;
constexpr size_t WS_MIX = 288 * MiB;
constexpr size_t WS_Q = 288 * MiB;
constexpr size_t WS_AF = 384 * MiB;
constexpr size_t WS_AB = 448 * MiB;
constexpr size_t WS_IDX = 448 * MiB;
constexpr size_t WS_G = 464 * MiB;
constexpr size_t WS_END = 512 * MiB;

constexpr int LDS_BYTES = 147456;

typedef unsigned v2u __attribute__((ext_vector_type(2)));
typedef __bf16 bf16x2 __attribute__((ext_vector_type(2)));

__device__ __forceinline__ float bflo(unsigned w) { return __builtin_bit_cast(float, w << 16); }
__device__ __forceinline__ float bfhi(unsigned w) { return __builtin_bit_cast(float, w & 0xffff0000u); }
__device__ __forceinline__ float wave_sum(float v) {
#pragma unroll
    for (int o = 1; o < 64; o <<= 1) v += __shfl_xor(v, o);
    return v;
}
__device__ __forceinline__ float dot2_bf16(unsigned w, unsigned x, float acc) { return __builtin_amdgcn_fdot2_f32_bf16(__builtin_bit_cast(bf16x2, w), __builtin_bit_cast(bf16x2, x), acc, false); }
__device__ __forceinline__ float sigmoidf_(float x) { return 1.0f / (1.0f + __expf(-x)); }
__device__ __forceinline__ float gelu_tanh(float x) { const float u = 0.7978845608028654f * (x + 0.044715f * x * x * x); return 0.5f * x * (1.0f + tanhf(u)); }
__device__ __forceinline__ float gelu_erf(float x) { return 0.5f * x * (1.0f + erff(x * 0.7071067811865476f)); }

struct Args { const float* in[24]; float* out; unsigned char* ws; int ph_lo, ph_hi; };

__device__ __forceinline__ void p0_transpose_item(const float* W, int K, int N, bf16* WT, LAS float* scr, int item, int lane) {
    const int nblk = N / 32, kb = item / nblk, nb = item % nblk, k0 = 64 * kb, n0 = 32 * nb;
#pragma unroll 8
    for (int i = 0; i < 32; ++i) { const int kk = 2 * i + (lane >> 5); scr[kk * 33 + (lane & 31)] = W[(size_t)(k0 + kk) * N + n0 + (lane & 31)]; }
    asm volatile("s_waitcnt lgkmcnt(0)" ::: "memory");
    const int c = lane & 7;
#pragma unroll
    for (int j = 0; j < 4; ++j) { const int n = (lane >> 3) + 8 * j; const LAS float* s = scr + (8 * c) * 33 + n;
        v4u o; o.x = pk2(s[0 * 33], s[1 * 33]); o.y = pk2(s[2 * 33], s[3 * 33]); o.z = pk2(s[4 * 33], s[5 * 33]); o.w = pk2(s[6 * 33], s[7 * 33]);
        *(v4u*)(WT + (size_t)(n0 + n) * K + k0 + 8 * c) = o; }
    asm volatile("s_waitcnt lgkmcnt(0)" ::: "memory");
}
__device__ __forceinline__ void ln_row_bf16(const float* xrow, const float* g, const float* b, bf16* orow, int lane) {
    const f32x4* xr = (const f32x4*)xrow + lane;
    f32x4 v[4]; float s = 0.f;
#pragma unroll
    for (int j = 0; j < 4; ++j) { v[j] = xr[64 * j]; s += (v[j].x + v[j].y) + (v[j].z + v[j].w); }
    const float mean = wave_sum(s) * (1.f / DM); float s2 = 0.f;
#pragma unroll
    for (int j = 0; j < 4; ++j) { v[j] = v[j] - mean; s2 += (v[j].x * v[j].x + v[j].y * v[j].y) + (v[j].z * v[j].z + v[j].w * v[j].w); }
    const float rstd = 1.f / sqrtf(wave_sum(s2) * (1.f / DM) + LN_EPS);
#pragma unroll
    for (int j = 0; j < 4; ++j) { const int col = 4 * lane + 256 * j; const f32x4 gv = *(const f32x4*)(g + col), bv = *(const f32x4*)(b + col);
        const f32x4 o = v[j] * rstd * gv + bv; v2u w; w.x = pk2(o.x, o.y); w.y = pk2(o.z, o.w); *(v2u*)(orow + col) = w; }
}
__device__ __forceinline__ void phase0(const Args& a, LAS unsigned char* lds, int vcu, int G, int wave, int lane) {
    unsigned char* ws = a.ws;
    LAS float* scr = (LAS float*)(lds + wave * 16384);
    const int gw = vcu * NWAVES + wave, NGW = G * NWAVES;
    constexpr int I_IN = (DM / 64) * (D_IN / 32), I_OUT = (D_MIX / 64) * (DM / 32), I_Q = (DM / 64) * (D_Q / 32), I_G = 32 * 8;
    constexpr int NITEMS = I_IN + I_OUT + I_Q + I_G;
    for (int it = gw; it < NITEMS; it += NGW) {
        int r = it;
        if (r < I_IN) { p0_transpose_item(a.in[3], DM, D_IN, (bf16*)(ws + WS_WIN), scr, r, lane); continue; } r -= I_IN;
        if (r < I_OUT) { p0_transpose_item(a.in[14], D_MIX, DM, (bf16*)(ws + WS_WOUT), scr, r, lane); continue; } r -= I_OUT;
        if (r < I_Q) { p0_transpose_item(a.in[17], DM, D_Q, (bf16*)(ws + WS_WQ), scr, r, lane); continue; } r -= I_Q;
        { const int blk = r >> 3, sub = r & 7;
          const int d = blk >> 4, which = (blk >> 3) & 1, h = blk & 7;
          const float* W = (which ? a.in[8] : a.in[6]) + (size_t)(d * 8 + h) * 16384;
          p0_transpose_item(W, 128, 128, (bf16*)(ws + WS_GW) + (size_t)blk * 16384, scr, sub, lane); }
    }
    { const int gt = gw * 64 + lane, NGT = NGW * 64;
      for (int i = gt; i < 2 * 16384; i += NGT) { const float v = (i < 16384) ? a.in[18][i] : a.in[19][i - 16384]; bf16* dst = (i < 16384) ? (bf16*)(ws + WS_K1) + i : (bf16*)(ws + WS_K2) + (i - 16384); *dst = (bf16)f2bf(v); } }
    for (int m = gw; m < T; m += NGW) ln_row_bf16(a.in[0] + (size_t)m * DM, a.in[1], a.in[2], (bf16*)(ws + WS_H0) + (size_t)m * DM, lane);
}

struct EpiIn {
    static constexpr bool PERM = true, AFTER_DRAIN = false;
    bf16 *XR, *GATE, *MIX, *CCX;
    __device__ __forceinline__ void operator()(const pg8::f32x4 (&acc)[2][2][4][2], const pg8::Unit& u, int wr, int wc, int fr, int fq) const {
        const int row0 = u.pm * 256 + wr * 64 + fr; const int pn = u.pn;
        bf16* base; int ldc, colt;
        if (pn < 4) { base = XR; ldc = 1024; colt = pn * 256; }
        else if (pn < 8) { base = GATE; ldc = 1024; colt = (pn - 4) * 256; }
        else if (pn < 10) { base = MIX; ldc = 1536; colt = 1024 + (pn - 8) * 256; }
        else { base = CCX; ldc = 1024; colt = (pn - 10) * 256; }
        const int col0 = colt + wc * 32 + 8 * fq;
#pragma unroll
        for (int ai = 0; ai < 2; ++ai)
#pragma unroll
            for (int m = 0; m < 4; ++m) { bf16* rowp = base + (size_t)(row0 + ai * 128 + m * 16) * ldc + col0;
#pragma unroll
                for (int bj = 0; bj < 2; ++bj) { const pg8::f32x4 v0 = acc[ai][bj][m][0], v1 = acc[ai][bj][m][1];
                    pg8::u32x4 w; w.x = pg8::cvt_pk_bf16(v0[0], v0[1]); w.y = pg8::cvt_pk_bf16(v0[2], v0[3]); w.z = pg8::cvt_pk_bf16(v1[0], v1[1]); w.w = pg8::cvt_pk_bf16(v1[2], v1[3]);
                    *(pg8::u32x4*)(rowp + bj * 128) = w; } }
    }
};
struct EpiPre {
    static constexpr bool PERM = false, AFTER_DRAIN = false;
    const bf16* H0; float* PRE;
    __device__ __forceinline__ void operator()(const pg8::f32x4 (&acc)[2][2][4][2], const pg8::Unit& u, int wr, int wc, int fr, int fq) const {
        const int row0 = u.pm * 256 + wr * 64 + fr, col0 = u.pn * 256 + wc * 32 + 4 * fq;
#pragma unroll
        for (int ai = 0; ai < 2; ++ai)
#pragma unroll
            for (int m = 0; m < 4; ++m) { const size_t ro = (size_t)(row0 + ai * 128 + m * 16) * DM + col0;
#pragma unroll
                for (int bj = 0; bj < 2; ++bj)
#pragma unroll
                    for (int n = 0; n < 2; ++n) { const v2u hw = *(const v2u*)(H0 + ro + bj * 128 + n * 16);
                        pg8::f32x4 o = acc[ai][bj][m][n];
                        o[0] += ALPHA * bflo(hw.x); o[1] += ALPHA * bfhi(hw.x); o[2] += ALPHA * bflo(hw.y); o[3] += ALPHA * bfhi(hw.y);
                        *(pg8::f32x4*)(PRE + ro + bj * 128 + n * 16) = o; } }
    }
};

constexpr int P2_XRT = 0, P2_XC = 18432, P2_AS = 36864, P2_US = 69632, P2_HF = 102400, P2_SEG = 135168;
constexpr int XC_PITCH = 272;
__device__ __forceinline__ void phase2(const Args& a, LAS unsigned char* lds, int vcu, int G, int tid, int wave, int lane) {
    unsigned char* ws = a.ws;
    const bf16* XR = (const bf16*)(ws + WS_XR);
    const bf16* GW = (const bf16*)(ws + WS_GW);
    bf16* AFp = (bf16*)(ws + WS_AF); bf16* ABp = (bf16*)(ws + WS_AB); bf16* MIX = (bf16*)(ws + WS_MIX);
    float* SUMM = (float*)(ws + WS_SUMM);
    const float* convw = a.in[4]; const float* convb = a.in[5]; const float* ba = a.in[7]; const float* bx = a.in[9]; const float* lam = a.in[10];
    LAS unsigned char* XRT = lds + P2_XRT; LAS unsigned char* XC = lds + P2_XC;
    LAS float* AS = (LAS float*)(lds + P2_AS); LAS float* US = (LAS float*)(lds + P2_US); LAS float* HF = (LAS float*)(lds + P2_HF); LAS float* SEG = (LAS float*)(lds + P2_SEG);
    for (int it = vcu; it < BATCH * NCHUNK * 8; it += G) {
        const int h = it & 7, c = (it >> 3) & 63, b = it >> 9;
        const int t0 = c * LCH; const size_t rowb = (size_t)b * SEQ;
        for (int q = tid; q < 70 * 16; q += NTHREADS) { const int r = q >> 4, cc = q & 15; const int t = t0 - 3 + r;
            v4u v = (v4u){0u, 0u, 0u, 0u};
            if (t >= 0 && t < SEQ) v = *(const v4u*)(XR + (rowb + t) * DM + h * 128 + cc * 8);
            *(LAS v4u*)(XRT + r * 256 + cc * 16) = v; }
        __syncthreads();
#pragma unroll 1
        for (int d = 0; d < 2; ++d) {
            { const int ch2 = tid & 63, tq = tid >> 6; const int gch = h * 128 + 2 * ch2;
              float w0[4], w1[4];
#pragma unroll
              for (int k = 0; k < 4; ++k) { w0[k] = convw[(d * 4 + k) * DM + gch]; w1[k] = convw[(d * 4 + k) * DM + gch + 1]; }
              const float b0 = convb[d * DM + gch], b1 = convb[d * DM + gch + 1];
              const int rbase = tq * 8 + (d ? 3 : 0);
              unsigned xw[11];
#pragma unroll
              for (int i = 0; i < 11; ++i) xw[i] = *(const LAS unsigned*)(XRT + (rbase + i) * 256 + ch2 * 4);
#pragma unroll
              for (int i = 0; i < 8; ++i) { float s0 = b0, s1 = b1;
#pragma unroll
                  for (int k = 0; k < 4; ++k) { s0 += w0[k] * bflo(xw[i + k]); s1 += w1[k] * bfhi(xw[i + k]); }
                  *(LAS unsigned*)(XC + (tq * 8 + i) * XC_PITCH + ch2 * 4) = pk2(s0, s1); } }
            __syncthreads();
            { pg8::f32x4 accr[4], acci[4];
#pragma unroll
              for (int m = 0; m < 4; ++m) { accr[m] = (pg8::f32x4){0.f, 0.f, 0.f, 0.f}; acci[m] = (pg8::f32x4){0.f, 0.f, 0.f, 0.f}; }
              const bf16* gwa = GW + (size_t)((d * 2 + 0) * 8 + h) * 16384 + (16 * wave + (lane & 15)) * 128 + 8 * (lane >> 4);
              const bf16* gwx = GW + (size_t)((d * 2 + 1) * 8 + h) * 16384 + (16 * wave + (lane & 15)) * 128 + 8 * (lane >> 4);
#pragma unroll
              for (int ks = 0; ks < 4; ++ks) { const bf16x8 bA = *(const bf16x8*)(gwa + ks * 32), bX = *(const bf16x8*)(gwx + ks * 32);
#pragma unroll
                  for (int m = 0; m < 4; ++m) { const bf16x8 af = *(const LAS bf16x8*)(XC + (16 * m + (lane & 15)) * XC_PITCH + (ks * 32 + 8 * (lane >> 4)) * 2);
                      accr[m] = __builtin_amdgcn_mfma_f32_16x16x32_bf16(af, bA, accr[m], 0, 0, 0);
                      acci[m] = __builtin_amdgcn_mfma_f32_16x16x32_bf16(af, bX, acci[m], 0, 0, 0); } }
              const int ch = 16 * wave + (lane & 15), gch = h * 128 + ch;
              const float bav = ba[d * DM + gch], bxv = bx[d * DM + gch];
              const float lm = lam[d * DM + gch]; const float sp = log1pf(__expf(-lm));
#pragma unroll
              for (int m = 0; m < 4; ++m)
#pragma unroll
                  for (int j = 0; j < 4; ++j) { const int tt = 16 * m + 4 * (lane >> 4) + j;
                      const float r = sigmoidf_(accr[m][j] + bav), ig = sigmoidf_(acci[m][j] + bxv);
                      const float la = -8.0f * r * sp; const float av = __expf(la);
                      const float xcv = __builtin_bit_cast(float, (unsigned)(*(const LAS unsigned short*)(XC + tt * XC_PITCH + ch * 2)) << 16);
                      const float t2 = 2.0f * la; const float om = (t2 > -0.0625f) ? -t2 * (1.0f + 0.5f * t2 * (1.0f + 0.33333334f * t2 * (1.0f + 0.25f * t2))) : 1.0f - av * av;
                      const float uv = sqrtf(om) * ig * xcv;
                      AS[tt * 128 + ch] = av; US[tt * 128 + ch] = uv; } }
            __syncthreads();
            { const int ch = tid & 127, seg = tid >> 7; const int gch = h * 128 + ch;
              float p = 1.f, hh = 0.f;
#pragma unroll
              for (int k = 0; k < 16; ++k) { const int tt = seg * 16 + (d ? 15 - k : k); const float av = AS[tt * 128 + ch], uv = US[tt * 128 + ch];
                  hh = av * hh + uv; p *= av; AS[tt * 128 + ch] = p; US[tt * 128 + ch] = hh; }
              SEG[(seg * 128 + ch) * 2] = p; SEG[(seg * 128 + ch) * 2 + 1] = hh;
              __syncthreads();
              float cp = 1.f, chh = 0.f;
              if (d == 0) { for (int s = 0; s < seg; ++s) { const float sp_ = SEG[(s * 128 + ch) * 2], sh = SEG[(s * 128 + ch) * 2 + 1]; chh = sp_ * chh + sh; cp *= sp_; } }
              else { for (int s = 3; s > seg; --s) { const float sp_ = SEG[(s * 128 + ch) * 2], sh = SEG[(s * 128 + ch) * 2 + 1]; chh = sp_ * chh + sh; cp *= sp_; } }
              bf16* Aout = d ? ABp : AFp;
#pragma unroll 2
              for (int k = 0; k < 16; ++k) { const int tt = seg * 16 + k; const float pv = AS[tt * 128 + ch], hv = US[tt * 128 + ch];
                  const float hfix = hv + pv * chh, pfix = pv * cp; const size_t grow = rowb + t0 + tt;
                  Aout[grow * DM + gch] = (bf16)f2bf(pfix);
                  if (d == 0) HF[tt * 128 + ch] = hfix; else MIX[grow * D_MIX + gch] = (bf16)f2bf(HF[tt * 128 + ch] + hfix);
                  if ((d == 0 && tt == 63) || (d == 1 && tt == 0)) { float* sm = SUMM + ((size_t)((b * NCHUNK + c) * 2 + d) * 2) * DM + gch; sm[0] = pfix; sm[DM] = hfix; } } }
            __syncthreads();
        }
    }
}
__device__ __forceinline__ void phase2b(const Args& a, int vcu, int G, int tid) {
    const float* SUMM = (const float*)(a.ws + WS_SUMM); float* CARRY = (float*)(a.ws + WS_CARRY);
    for (int i = vcu * NTHREADS + tid; i < BATCH * 2 * DM; i += G * NTHREADS) {
        const int ch = i & 1023, d = (i >> 10) & 1, b = i >> 11; float cv = 0.f;
        for (int k = 0; k < NCHUNK; ++k) { const int c = d ? NCHUNK - 1 - k : k;
            CARRY[(size_t)((b * NCHUNK + c) * 2 + d) * DM + ch] = cv;
            const float* sm = SUMM + ((size_t)((b * NCHUNK + c) * 2 + d) * 2) * DM + ch; cv = sm[0] * cv + sm[DM]; }
    }
}
__device__ __forceinline__ void phase3(const Args& a, int vcu, int G, int wave, int lane) {
    unsigned char* ws = a.ws;
    bf16* MIX = (bf16*)(ws + WS_MIX); const bf16* AFp = (const bf16*)(ws + WS_AF); const bf16* ABp = (const bf16*)(ws + WS_AB);
    const bf16* GATE = (const bf16*)(ws + WS_GATE); const bf16* CCX = (const bf16*)(ws + WS_CCX); const float* CARRY = (const float*)(ws + WS_CARRY);
    const float* cw = a.in[11]; const float* gnl = a.in[12]; const float* gnc = a.in[13];
    for (int item = vcu; item < BATCH * NCHUNK; item += G) {
        const int b = item >> 6, c = item & 63; const size_t row0 = (size_t)b * SEQ + c * LCH;
        float cf[16], cb[16], gn[16], w3[3][8], gc[8];
#pragma unroll
        for (int hf = 0; hf < 2; ++hf)
#pragma unroll
            for (int q = 0; q < 2; ++q) { const int ch = hf * 512 + 8 * lane + 4 * q;
                const f32x4 f = *(const f32x4*)(CARRY + (size_t)((b * NCHUNK + c) * 2 + 0) * DM + ch), bk = *(const f32x4*)(CARRY + (size_t)((b * NCHUNK + c) * 2 + 1) * DM + ch), g = *(const f32x4*)(gnl + ch);
#pragma unroll
                for (int i = 0; i < 4; ++i) { cf[hf * 8 + q * 4 + i] = f[i]; cb[hf * 8 + q * 4 + i] = bk[i]; gn[hf * 8 + q * 4 + i] = g[i]; } }
#pragma unroll
        for (int q = 0; q < 2; ++q) { const int ch = 8 * lane + 4 * q; const f32x4 g = *(const f32x4*)(gnc + ch);
#pragma unroll
            for (int k = 0; k < 3; ++k) { const f32x4 w = *(const f32x4*)(cw + k * 512 + ch);
#pragma unroll
                for (int i = 0; i < 4; ++i) w3[k][q * 4 + i] = w[i]; }
#pragma unroll
            for (int i = 0; i < 4; ++i) gc[q * 4 + i] = g[i]; }
#pragma unroll 1
        for (int tt = wave; tt < LCH; tt += NWAVES) {
            const size_t row = row0 + tt; const int tpos = c * LCH + tt;
            float y[16]; float ss = 0.f;
#pragma unroll
            for (int hf = 0; hf < 2; ++hf) { const int ch = hf * 512 + 8 * lane;
                const v4u sv = *(const v4u*)(MIX + row * D_MIX + ch), fv = *(const v4u*)(AFp + row * DM + ch), bv = *(const v4u*)(ABp + row * DM + ch), gv = *(const v4u*)(GATE + row * DM + ch);
#pragma unroll
                for (int i = 0; i < 4; ++i) { const int e = hf * 8 + 2 * i;
                    const float l0 = bflo(sv[i]) + bflo(fv[i]) * cf[e] + bflo(bv[i]) * cb[e], l1 = bfhi(sv[i]) + bfhi(fv[i]) * cf[e + 1] + bfhi(bv[i]) * cb[e + 1];
                    y[e] = gelu_tanh(bflo(gv[i])) * l0; y[e + 1] = gelu_tanh(bfhi(gv[i])) * l1; ss += y[e] * y[e] + y[e + 1] * y[e + 1]; } }
            const float r = 1.0f / sqrtf(wave_sum(ss) * (1.f / 1024.f) + RMS_EPS);
#pragma unroll
            for (int hf = 0; hf < 2; ++hf) { v4u o;
#pragma unroll
                for (int i = 0; i < 4; ++i) { const int e = hf * 8 + 2 * i; o[i] = pk2(y[e] * r * gn[e], y[e + 1] * r * gn[e + 1]); }
                *(v4u*)(MIX + row * D_MIX + hf * 512 + 8 * lane) = o; }
            float acc[8];
#pragma unroll
            for (int i = 0; i < 8; ++i) acc[i] = 0.f;
#pragma unroll
            for (int k = 0; k < 3; ++k) { const int tp = tpos + k - 1;
                if (tp >= 0 && tp < SEQ) { const v4u cv = *(const v4u*)(CCX + (row + k - 1) * DM + 8 * lane), xv = *(const v4u*)(CCX + (row + k - 1) * DM + 512 + 8 * lane);
#pragma unroll
                    for (int i = 0; i < 4; ++i) { acc[2 * i] += w3[k][2 * i] * bflo(cv[i]) * bflo(xv[i]); acc[2 * i + 1] += w3[k][2 * i + 1] * bfhi(cv[i]) * bfhi(xv[i]); } } }
            const v4u cbv = *(const v4u*)(MIX + row * D_MIX + 1024 + 8 * lane); float ssc = 0.f;
#pragma unroll
            for (int i = 0; i < 4; ++i) { acc[2 * i] *= bflo(cbv[i]); acc[2 * i + 1] *= bfhi(cbv[i]); ssc += acc[2 * i] * acc[2 * i] + acc[2 * i + 1] * acc[2 * i + 1]; }
            const float r2 = 1.0f / sqrtf(wave_sum(ssc) * (1.f / 512.f) + RMS_EPS);
            v4u oc;
#pragma unroll
            for (int i = 0; i < 4; ++i) oc[i] = pk2(acc[2 * i] * r2 * gc[2 * i], acc[2 * i + 1] * r2 * gc[2 * i + 1]);
            *(v4u*)(MIX + row * D_MIX + 1024 + 8 * lane) = oc;
        }
    }
}
__device__ __forceinline__ void phase5(const Args& a, int vcu, int G, int tid, int wave, int lane) {
    unsigned char* ws = a.ws;
    const int gw = vcu * NWAVES + wave, NGW = G * NWAVES;
    for (int m = gw; m < T; m += NGW) ln_row_bf16((const float*)(ws + WS_PRE1) + (size_t)m * DM, a.in[15], a.in[16], (bf16*)(ws + WS_H1) + (size_t)m * DM, lane);
    const size_t NV = (size_t)16384 * 1024 / 8;
    for (size_t i = (size_t)vcu * NTHREADS + tid; i < 2 * NV; i += (size_t)G * NTHREADS) {
        const bool second = i >= NV; const size_t j = second ? i - NV : i;
        const float* src = (second ? a.in[21] : a.in[20]) + j * 8; bf16* dst = (bf16*)(ws + (second ? WS_V16 : WS_U16)) + j * 8;
        const f32x4 v0 = *(const f32x4*)src, v1 = *(const f32x4*)(src + 4);
        v4u o; o.x = pk2(v0.x, v0.y); o.y = pk2(v0.z, v0.w); o.z = pk2(v1.x, v1.y); o.w = pk2(v1.z, v1.w); *(v4u*)dst = o; }
}
#define INS16(v, x) do { _Pragma("unroll") for (int j_ = 15; j_ >= 1; --j_) v[j_] = __builtin_amdgcn_fmed3f(v[j_ - 1], v[j_], (x)); v[0] = fmaxf(v[0], (x)); } while (0)
constexpr int P7_S1 = 0, P7_S2 = 64 * 129 * 4, P7_TL = 2 * 64 * 129 * 4;
__device__ __forceinline__ void phase7(const Args& a, LAS unsigned char* lds, int vcu, int G, int tid, int wave, int lane) {
    unsigned char* ws = a.ws;
    const bf16* Q = (const bf16*)(ws + WS_Q); const bf16* K1 = (const bf16*)(ws + WS_K1); const bf16* K2 = (const bf16*)(ws + WS_K2);
    int* IDX = (int*)(ws + WS_IDX); float* Gp = (float*)(ws + WS_G);
    LAS float* S1 = (LAS float*)(lds + P7_S1); LAS float* S2 = (LAS float*)(lds + P7_S2); LAS float* TL = (LAS float*)(lds + P7_TL);
    for (int item = vcu; item < (T / 64) * 8; item += G) {
        const int h = item & 7, tile = item >> 3; const size_t row0 = (size_t)tile * 64;
#pragma unroll
        for (int half = 0; half < 2; ++half) {
            const bf16* Kb = (half ? K2 : K1) + (16 * wave + (lane & 15)) * 128 + 8 * (lane >> 4);
            const bf16* Qb = Q + (row0 + (lane & 15)) * D_Q + h * 256 + half * 128 + 8 * (lane >> 4);
            pg8::f32x4 acc[4];
#pragma unroll
            for (int m = 0; m < 4; ++m) acc[m] = (pg8::f32x4){0.f, 0.f, 0.f, 0.f};
#pragma unroll
            for (int ks = 0; ks < 4; ++ks) { const bf16x8 bf = *(const bf16x8*)(Kb + ks * 32);
#pragma unroll
                for (int m = 0; m < 4; ++m) { const bf16x8 af = *(const bf16x8*)(Qb + (size_t)(16 * m) * D_Q + ks * 32);
                    acc[m] = __builtin_amdgcn_mfma_f32_16x16x32_bf16(af, bf, acc[m], 0, 0, 0); } }
            LAS float* S = half ? S2 : S1;
#pragma unroll
            for (int m = 0; m < 4; ++m)
#pragma unroll
                for (int j = 0; j < 4; ++j) S[(16 * m + 4 * (lane >> 4) + j) * 129 + 16 * wave + (lane & 15)] = acc[m][j];
        }
        __syncthreads();
        if (tid < 128) { const int token = tid & 63, list = tid >> 6; const LAS float* srow = (list ? S2 : S1) + token * 129;
            float v[16];
#pragma unroll
            for (int j = 0; j < 16; ++j) v[j] = -3.0e38f;
#pragma unroll 4
            for (int k = 0; k < 128; ++k) { const float key = __builtin_bit_cast(float, (__builtin_bit_cast(unsigned, srow[k]) & ~0x7Fu) | (unsigned)k); INS16(v, key); }
#pragma unroll
            for (int j = 0; j < 16; ++j) TL[(list * 64 + token) * 17 + j] = v[j]; }
        __syncthreads();
        if (tid < 64) { const int token = tid; float va[16], vb[16], cnd[16];
#pragma unroll
            for (int j = 0; j < 16; ++j) { va[j] = __builtin_bit_cast(float, __builtin_bit_cast(unsigned, TL[token * 17 + j]) & ~0x7Fu); vb[j] = __builtin_bit_cast(float, __builtin_bit_cast(unsigned, TL[(64 + token) * 17 + j]) & ~0x7Fu); cnd[j] = -3.0e38f; }
#pragma unroll
            for (int i = 0; i < 16; ++i)
#pragma unroll
                for (int j = 0; j < 16; ++j) if ((i + 1) * (j + 1) <= 16) { const float key = __builtin_bit_cast(float, (__builtin_bit_cast(unsigned, va[i] + vb[j]) & ~0xFFu) | (unsigned)(i * 16 + j)); INS16(cnd, key); }
            float e[16]; float sum = 0.f; const float mx = __builtin_bit_cast(float, __builtin_bit_cast(unsigned, cnd[0]) & ~0xFFu);
            int ids[16];
#pragma unroll
            for (int k = 0; k < 16; ++k) { const unsigned bits = __builtin_bit_cast(unsigned, cnd[k]); const int pi = (bits >> 4) & 15, pj = bits & 15;
                const float val = __builtin_bit_cast(float, bits & ~0xFFu); e[k] = __expf(val - mx); sum += e[k];
                const int i1 = (int)(__builtin_bit_cast(unsigned, TL[token * 17 + pi]) & 0x7Fu), i2 = (int)(__builtin_bit_cast(unsigned, TL[(64 + token) * 17 + pj]) & 0x7Fu);
                ids[k] = i1 * 128 + i2; }
            const float inv = 1.0f / sum; const size_t o = (row0 + token) * 128 + h * 16;
#pragma unroll
            for (int k = 0; k < 16; k += 4) { *(v4u*)(IDX + o + k) = (v4u){(unsigned)ids[k], (unsigned)ids[k + 1], (unsigned)ids[k + 2], (unsigned)ids[k + 3]};
                *(f32x4*)(Gp + o + k) = (f32x4){e[k] * inv, e[k + 1] * inv, e[k + 2] * inv, e[k + 3] * inv}; } }
        __syncthreads();
    }
}
__device__ __forceinline__ void phase8(const Args& a, int vcu, int G, int wave, int lane) {
    unsigned char* ws = a.ws;
    const bf16* H1 = (const bf16*)(ws + WS_H1); const bf16* U16 = (const bf16*)(ws + WS_U16); const bf16* V16 = (const bf16*)(ws + WS_V16);
    const int* IDX = (const int*)(ws + WS_IDX); const float* Gp = (const float*)(ws + WS_G);
    const float* g2 = a.in[22]; const float* b2 = a.in[23];
    const int gw = vcu * NWAVES + wave, NGW = G * NWAVES;
    for (int t = gw; t < T; t += NGW) {
        const v4u x0 = *(const v4u*)(H1 + (size_t)t * DM + 8 * lane), x1 = *(const v4u*)(H1 + (size_t)t * DM + 512 + 8 * lane);
        float y[16];
#pragma unroll
        for (int i = 0; i < 16; ++i) y[i] = 0.f;
#pragma unroll 1
        for (int part = 0; part < 2; ++part) {
            const int idr = IDX[(size_t)t * 128 + part * 64 + lane]; const float gr = Gp[(size_t)t * 128 + part * 64 + lane];
#pragma unroll 2
            for (int e = 0; e < 64; ++e) {
                const int ie = __builtin_amdgcn_readlane(idr, e); const float ge = __builtin_bit_cast(float, __builtin_amdgcn_readlane(__builtin_bit_cast(int, gr), e));
                const bf16* ur = U16 + (size_t)ie * DM; const bf16* vr = V16 + (size_t)ie * DM;
                const v4u ua = *(const v4u*)(ur + 8 * lane), ub = *(const v4u*)(ur + 512 + 8 * lane);
                const v4u va = *(const v4u*)(vr + 8 * lane), vb = *(const v4u*)(vr + 512 + 8 * lane);
                float d0 = 0.f, d1 = 0.f;
#pragma unroll
                for (int i = 0; i < 4; ++i) { d0 = dot2_bf16(ua[i], x0[i], d0); d1 = dot2_bf16(ub[i], x1[i], d1); }
                const float dot = wave_sum(d0 + d1);
                const float w = ge * gelu_erf(dot);
#pragma unroll
                for (int i = 0; i < 4; ++i) { y[2 * i] += w * bflo(va[i]); y[2 * i + 1] += w * bfhi(va[i]); y[8 + 2 * i] += w * bflo(vb[i]); y[8 + 2 * i + 1] += w * bfhi(vb[i]); }
            }
        }
        float s = 0.f;
#pragma unroll
        for (int i = 0; i < 4; ++i) { y[2 * i] += ALPHA * bflo(x0[i]); y[2 * i + 1] += ALPHA * bfhi(x0[i]); y[8 + 2 * i] += ALPHA * bflo(x1[i]); y[8 + 2 * i + 1] += ALPHA * bfhi(x1[i]); }
#pragma unroll
        for (int i = 0; i < 16; ++i) s += y[i];
        const float mean = wave_sum(s) * (1.f / DM); float s2 = 0.f;
#pragma unroll
        for (int i = 0; i < 16; ++i) { y[i] -= mean; s2 += y[i] * y[i]; }
        const float rstd = 1.0f / sqrtf(wave_sum(s2) * (1.f / DM) + LN_EPS);
#pragma unroll
        for (int hf = 0; hf < 2; ++hf)
#pragma unroll
            for (int q = 0; q < 2; ++q) { const int col = hf * 512 + 8 * lane + 4 * q; const f32x4 gv = *(const f32x4*)(g2 + col), bv = *(const f32x4*)(b2 + col);
                f32x4 o;
#pragma unroll
                for (int i = 0; i < 4; ++i) o[i] = y[hf * 8 + q * 4 + i] * rstd * gv[i] + bv[i];
                *(f32x4*)(a.out + (size_t)t * DM + col) = o; }
    }
}

constexpr int NPHASES = 10;
__global__ void __launch_bounds__(NTHREADS, 2) hymba_fwd(Args args) {
    extern __shared__ __attribute__((aligned(16))) unsigned char lds_raw[];
    LAS unsigned char* lds = (LAS unsigned char*)lds_raw;
    const int tid = threadIdx.x, lane = tid & 63, wave = __builtin_amdgcn_readfirstlane(tid >> 6);
    const int G = gridDim.x; const int bx = blockIdx.x; const int vcu = (G % 8 == 0) ? (bx % 8) * (G / 8) + bx / 8 : bx;
    unsigned char* ws = args.ws;
    const int lo = args.ph_lo, hi = args.ph_hi;
#define IN(k) (lo <= (k) && (k) < hi)
#ifdef ONLY
#define PH_ON(k) ((k) == ONLY)
#else
#define PH_ON(k) true
#endif
#define SEAM(k) do { if (IN(k) && IN((k) + 1)) { GRID_SYNC(); } } while (0)
    if (PH_ON(0) && IN(0)) { phase0(args, lds, vcu, G, wave, lane); } SEAM(0);
    if (PH_ON(1) && IN(1)) { pg8::Gemm g{(const bf16*)(ws + WS_H0), (const bf16*)(ws + WS_WIN), T, D_IN, DM}; pg8::StaticOrder S; S.init(T, D_IN, G, bx);
        EpiIn E{(bf16*)(ws + WS_XR), (bf16*)(ws + WS_GATE), (bf16*)(ws + WS_MIX), (bf16*)(ws + WS_CCX)};
        pg8::gemm_phase<EpiIn, pg8::StaticOrder, true, true>(lds, g, S, E); } SEAM(1);
    if (PH_ON(2) && IN(2)) { phase2(args, lds, vcu, G, tid, wave, lane); } SEAM(2);
    if (PH_ON(3) && IN(3)) { phase2b(args, vcu, G, tid); } SEAM(3);
    if (PH_ON(4) && IN(4)) { phase3(args, vcu, G, wave, lane); } SEAM(4);
    if (PH_ON(5) && IN(5)) { pg8::Gemm g{(const bf16*)(ws + WS_MIX), (const bf16*)(ws + WS_WOUT), T, DM, D_MIX}; pg8::StaticOrder S; S.init(T, DM, G, bx);
        EpiPre E{(const bf16*)(ws + WS_H0), (float*)(ws + WS_PRE1)};
        pg8::gemm_phase<EpiPre, pg8::StaticOrder, true, true>(lds, g, S, E); } SEAM(5);
    if (PH_ON(6) && IN(6)) { phase5(args, vcu, G, tid, wave, lane); } SEAM(6);
    if (PH_ON(7) && IN(7)) { pg8::Gemm g{(const bf16*)(ws + WS_H1), (const bf16*)(ws + WS_WQ), T, D_Q, DM}; pg8::StaticOrder S; S.init(T, D_Q, G, bx);
        pg8::EpiBf16<0> E{(bf16*)(ws + WS_Q), D_Q, nullptr, 0, 0, 1.f};
        pg8::gemm_phase<pg8::EpiBf16<0>, pg8::StaticOrder, true, true>(lds, g, S, E); } SEAM(7);
    if (PH_ON(8) && IN(8)) { phase7(args, lds, vcu, G, tid, wave, lane); } SEAM(8);
    if (PH_ON(9) && IN(9)) { phase8(args, vcu, G, wave, lane); }
#undef IN
#undef SEAM
}

extern "C" void kernel_launch(void* const* d_in, const int* in_sizes, int n_in, void* d_out, int out_size, void* d_ws, size_t ws_size, hipStream_t stream) {
    static int grid = 0;
    if (grid == 0) {
        if (n_in != 24 || out_size != T * DM || ws_size < WS_END) { fprintf(stderr, "kernel_launch: unexpected shapes n_in %d out %d ws %zu\n", n_in, out_size, ws_size); grid = -1; return; }
        int dev = 0, cus = 0, per_cu = 0;
        (void)hipGetDevice(&dev); (void)hipDeviceGetAttribute(&cus, hipDeviceAttributeMultiprocessorCount, dev);
        if (hipFuncSetAttribute((const void*)hymba_fwd, hipFuncAttributeMaxDynamicSharedMemorySize, LDS_BYTES) != hipSuccess) { fprintf(stderr, "hipFuncSetAttribute failed\n"); grid = -1; return; }
        (void)hipOccupancyMaxActiveBlocksPerMultiprocessor(&per_cu, (const void*)hymba_fwd, NTHREADS, LDS_BYTES);
        (void)hipGetLastError();
        if (per_cu < 1) { fprintf(stderr, "occupancy query says %d blocks per CU\n", per_cu); grid = -1; return; }
        grid = cus;
    }
    if (grid < 0) return;
    Args a{};
    for (int i = 0; i < 24; ++i) a.in[i] = (const float*)d_in[i];
    a.out = (float*)d_out; a.ws = (unsigned char*)d_ws;
#if ONE_LAUNCH
    (void)hipMemsetAsync((char*)d_ws + WS_CTL, 0, CTL_ZERO_BYTES, stream);
    a.ph_lo = 0; a.ph_hi = NPHASES;
    void* kargs[] = {&a};
    hipError_t e = hipLaunchCooperativeKernel((const void*)hymba_fwd, dim3(grid), dim3(NTHREADS), kargs, LDS_BYTES, stream);
    if (e != hipSuccess) fprintf(stderr, "cooperative launch failed: %s (grid %d)\n", hipGetErrorString(e), grid);
#else
    for (int p = 0; p < NPHASES; ++p) { a.ph_lo = p; a.ph_hi = p + 1; hipLaunchKernelGGL(hymba_fwd, dim3(grid), dim3(NTHREADS), LDS_BYTES, stream, a); }
#endif
}
```

```cpp
#include <hip/hip_runtime.h>
#include <hip/hip_cooperative_groups.h>
#include <cstdio>
#include <cstdint>
#include <cmath>
#ifndef ONE_LAUNCH
#define ONE_LAUNCH 1
#endif
#ifndef WT_STORES
#define WT_STORES 1
#endif
#if WT_STORES
#define ST16_WT(p, v) asm volatile("global_store_dwordx4 %0, %1, off sc1\n\ts_nop 1" :: "v"(p), "v"(v) : "memory")
#else
#define ST16_WT(p, v) (*(decltype(v)*)(p) = (v))
#endif
#if WT_STORES
#define ST16_WTB(rs, off, v) __builtin_amdgcn_raw_buffer_store_b128((v), (rs), (off), 0, 16)
#else
#define ST16_WTB(rs, off, v) __builtin_amdgcn_raw_buffer_store_b128((v), (rs), (off), 0, 0)
#endif
namespace pg8 {
#define PG8_LAS __attribute__((address_space(3)))
typedef unsigned short bf16_t;
typedef short bf16x8 __attribute__((ext_vector_type(8)));
typedef float f32x4 __attribute__((ext_vector_type(4)));
typedef unsigned u32x4 __attribute__((ext_vector_type(4)));
constexpr int BM = 256, BK = 64, HALF = 128, HTB = HALF * BK * 2  , STAGE_BYTES = 8 * HTB, NXCD = 8, WGM = 8;

__host__ __device__ __forceinline__ int lds_byte(int r, int c) { const int st = (r >> 4) * 2 + (c >> 5), rr = r & 15, cc = c & 31, ob = rr * 64 + cc * 2; return st * 1024 + (ob ^ (((ob >> 9) & 1) << 5)); }
__host__ __device__ __forceinline__ void stage_rc(int b, int& R, int& C) { const int st = b / 1024, sb = b % 1024, swz = sb ^ (((sb >> 9) & 1) << 5); R = (st >> 1) * 16 + swz / 64; C = (st & 1) * 32 + (swz % 64) / 2; }
__host__ __device__ __forceinline__ int perm32(int rho) { const int n = rho >> 4, i = rho & 15; return 8 * (i >> 2) + 4 * n + (i & 3); }

struct Unit { int pm, pn; };
struct Gemm { const bf16_t* A; const bf16_t* Bt; int M, N, K; };

struct StaticOrder {
    int nM, nN, nwg, G, c;
    __host__ __device__ void init(int M, int N, int G_, int c_) { nM = M / BM; nN = N / BM; nwg = nM * nN; G = G_; c = c_; }
    __host__ __device__ bool next(int i, Unit& u) const {
        const long L = (long)i * G + c; if (L >= nwg) return false;
        int wgid = (int)L; { const int q = nwg / NXCD, r = nwg % NXCD, xcd = wgid % NXCD, off = wgid / NXCD; wgid = (xcd < r ? xcd * (q + 1) : r * (q + 1) + (xcd - r) * q) + off; }
        const int nig = WGM * nN, gid = wgid / nig, fm = gid * WGM, gsz = (nM - fm) < WGM ? (nM - fm) : WGM;
        u.pm = fm + ((wgid % nig) % gsz); u.pn = (wgid % nig) / gsz; return true;
    }
    __device__ __forceinline__ void a_ready(const Unit&) const {}
    __device__ __forceinline__ void done(const Unit&) const {}
};

__device__ __forceinline__ unsigned cvt_pk_bf16(float lo, float hi) { unsigned r; asm volatile("v_cvt_pk_bf16_f32 %0, %1, %2" : "=v"(r) : "v"(lo), "v"(hi)); return r; }
typedef float f32x2 __attribute__((ext_vector_type(2)));
__device__ __forceinline__ f32x2 gelu_pk(f32x2 v) {
    const f32x2 av = __builtin_elementwise_abs(v), d = av * 0.2316418882f + 1.0f;
    f32x2 t; t.x = __builtin_amdgcn_rcpf(d.x); t.y = __builtin_amdgcn_rcpf(d.y);
    f32x2 q = t * 0.5307027145f + (-0.7265760135f); q = q * t + 0.7107068705f; q = q * t + (-0.142248368f); q = q * t + 0.127414796f; q = q * t;
    const f32x2 s = (v * v) * (-0.72134752044f);
    f32x2 e; e.x = __builtin_amdgcn_exp2f(s.x); e.y = __builtin_amdgcn_exp2f(s.y);
    const f32x2 m = v * (q * e), r = v - m;
    f32x2 o; o.x = v.x < 0.f ? m.x : r.x; o.y = v.y < 0.f ? m.y : r.y; return o;
}

template <int ACT  > struct EpiBf16 {
    static constexpr bool PERM = true, AFTER_DRAIN = false; static_assert(ACT == 0 || ACT == 1, "EpiBf16: ACT is 0 (none) or 1 (gelu_pk)");
    bf16_t* O; int ldc; const float* bias; int split_cols; size_t split_stride; float scale0;
    __device__ __forceinline__ void operator()(const f32x4 (&acc)[2][2][4][2], const Unit& u, int wr, int wc, int fr, int fq) const {
        const int row0 = u.pm * BM + wr * 64 + fr; int colt = u.pn * BM; bf16_t* base = O;
        float sc = 1.f; if (split_cols) { const int t = colt / split_cols; base += (size_t)t * split_stride; colt -= t * split_cols; if (t == 0) sc = scale0; }
        const int col0 = colt + wc * 32 + 8 * fq, bcol0 = u.pn * BM + wc * 32 + 8 * fq;
        f32x4 bv[2][2];
#pragma unroll
        for (int bj = 0; bj < 2; ++bj)
#pragma unroll
            for (int n = 0; n < 2; ++n) bv[bj][n] = bias ? *(const f32x4*)(bias + bcol0 + bj * HALF + 4 * n) : (f32x4){0.f, 0.f, 0.f, 0.f};
#pragma unroll
        for (int ai = 0; ai < 2; ++ai)
#pragma unroll
            for (int m = 0; m < 4; ++m) { bf16_t* rowp = base + (size_t)(row0 + ai * HALF + m * 16) * ldc + col0;
#pragma unroll
                for (int bj = 0; bj < 2; ++bj) { f32x4 v0 = acc[ai][bj][m][0] + bv[bj][0], v1 = acc[ai][bj][m][1] + bv[bj][1];
                    if (ACT == 1) { f32x2 a = gelu_pk((f32x2){v0[0], v0[1]}), b = gelu_pk((f32x2){v0[2], v0[3]}), c = gelu_pk((f32x2){v1[0], v1[1]}), d = gelu_pk((f32x2){v1[2], v1[3]});
                        v0 = (f32x4){a.x, a.y, b.x, b.y}; v1 = (f32x4){c.x, c.y, d.x, d.y}; }
                    v0 = v0 * sc; v1 = v1 * sc; u32x4 w; w.x = cvt_pk_bf16(v0[0], v0[1]); w.y = cvt_pk_bf16(v0[2], v0[3]); w.z = cvt_pk_bf16(v1[0], v1[1]); w.w = cvt_pk_bf16(v1[2], v1[3]);
                    ST16_WT(rowp + bj * HALF, w); } }
    }
};
template <class Epi, class Sched, bool ALIGN_EPI = false, bool SP2 = false>
__device__ __forceinline__ void gemm_phase(PG8_LAS unsigned char* lds, const Gemm g, const Sched& S, const Epi& E) {
    const int tid = threadIdx.x, wid = __builtin_amdgcn_readfirstlane(tid >> 6), lane = tid & 63, wr = wid >> 2, wc = wid & 3, fr = lane & 15, fq = lane >> 4;
    const int K = g.K, nt = K / BK;
    unsigned voffA[2], voffB[2];
#pragma unroll
    for (int i = 0; i < 2; ++i) { int R, C; stage_rc(tid * 16 + i * 8192, R, C); const int Rb = Epi::PERM ? ((R & ~31) + perm32(R & 31)) : R;
        voffA[i] = (unsigned)(R * K + C) * 2u; voffB[i] = (unsigned)(Rb * K + C) * 2u; }
    const size_t kstep = (size_t)(BK * 2);
    const size_t hstep = (size_t)HALF * K * 2;
    const size_t tstep = 2 * hstep;
    const unsigned ldsw = (unsigned)wid * 1024u;
    const int aoff = lds_byte(wr * 64 + fr, fq * 8), boff = lds_byte(wc * 32 + fr, fq * 8);
#define PG8_SA(b, h) (((b) * 2 + (h)) * HTB)
#define PG8_SB(b, h) ((4 + (b) * 2 + (h)) * HTB)
#define PG8_STAGE(bufoff, gbase, voff) do { _Pragma("unroll") for (int _i = 0; _i < 2; ++_i) \
        __builtin_amdgcn_global_load_lds((const unsigned*)((const char*)(gbase) + (voff)[_i]), (PG8_LAS unsigned*)(lds + (bufoff) + ldsw + _i * 8192), 16, 0, 0); } while (0)
#define PG8_LDA(dst, b, h) do { _Pragma("unroll") for (int m = 0; m < 4; ++m) _Pragma("unroll") for (int k = 0; k < 2; ++k) dst[m][k] = *(const PG8_LAS bf16x8*)(lds + PG8_SA(b, h) + aoff + m * 2048 + k * 1024); } while (0)
#define PG8_LDB(dst, b, h) do { _Pragma("unroll") for (int n = 0; n < 2; ++n) _Pragma("unroll") for (int k = 0; k < 2; ++k) dst[n][k] = *(const PG8_LAS bf16x8*)(lds + PG8_SB(b, h) + boff + n * 2048 + k * 1024); } while (0)
#define PG8_MMA(ai, bj, At, Bt) do { __builtin_amdgcn_s_setprio(1); _Pragma("unroll") for (int m = 0; m < 4; ++m) _Pragma("unroll") for (int n = 0; n < 2; ++n) _Pragma("unroll") for (int k = 0; k < 2; ++k) \
        acc[ai][bj][m][n] = __builtin_amdgcn_mfma_f32_16x16x32_bf16(Bt[n][k], At[m][k], acc[ai][bj][m][n], 0, 0, 0); __builtin_amdgcn_s_setprio(0); } while (0)
#define PG8_WAIT_V(n) asm volatile("s_waitcnt vmcnt(" #n ")" ::: "memory")
#define PG8_WAIT_L(n) asm volatile("s_waitcnt lgkmcnt(" #n ")" ::: "memory")
#define PG8_BAR __builtin_amdgcn_s_barrier()
#define PG8_SCHED __builtin_amdgcn_sched_barrier(0)
    Unit cur, nxt; int ui = 0;
    if (!S.next(0, cur)) return;
    f32x4 acc[2][2][4][2];
#pragma unroll
    for (int a = 0; a < 2; ++a)
#pragma unroll
        for (int b = 0; b < 2; ++b)
#pragma unroll
            for (int m = 0; m < 4; ++m)
#pragma unroll
                for (int n = 0; n < 2; ++n) acc[a][b][m][n] = (f32x4){0.f, 0.f, 0.f, 0.f};
    bf16x8 At[4][2], B0[2][2], B1[2][2];
    const char* cA = (const char*)g.A + (size_t)cur.pm * tstep; const char* cB = (const char*)g.Bt + (size_t)cur.pn * tstep;
    S.a_ready(cur);
    if constexpr (SP2) {
        PG8_STAGE(PG8_SB(0, 0), cB, voffB); PG8_STAGE(PG8_SB(0, 1), cB + hstep, voffB); PG8_STAGE(PG8_SA(0, 0), cA, voffA); PG8_STAGE(PG8_SA(0, 1), cA + hstep, voffA);
        if (wr == 1) PG8_BAR;
        PG8_WAIT_V(2); PG8_BAR;
        PG8_STAGE(PG8_SB(1, 0), cB + kstep, voffB); PG8_STAGE(PG8_SA(1, 0), cA + kstep, voffA); PG8_STAGE(PG8_SB(1, 1), cB + hstep + kstep, voffB);
        PG8_WAIT_V(6); PG8_BAR;
    } else {
        PG8_STAGE(PG8_SB(0, 0), cB, voffB); PG8_STAGE(PG8_SA(0, 0), cA, voffA); PG8_STAGE(PG8_SB(0, 1), cB + hstep, voffB); PG8_STAGE(PG8_SA(0, 1), cA + hstep, voffA);
        if (wr == 1) PG8_BAR;
        PG8_WAIT_V(4); PG8_BAR;
        PG8_STAGE(PG8_SB(1, 0), cB + kstep, voffB); PG8_STAGE(PG8_SA(1, 0), cA + kstep, voffA); PG8_STAGE(PG8_SB(1, 1), cB + hstep + kstep, voffB);
        PG8_WAIT_V(6); PG8_BAR;
    }
    for (;;) {
        const bool has_next = S.next(ui + 1, nxt);
        const char* nA = has_next ? (const char*)g.A + (size_t)nxt.pm * tstep : cA; const char* nB = has_next ? (const char*)g.Bt + (size_t)nxt.pn * tstep : cB;
        for (int t = 0; t < nt; t += 2) {
            const bool last = (t == nt - 2);
            const char* a1 = cA + (size_t)(t + 1) * kstep;
            const char* a2 = last ? nA : cA + (size_t)(t + 2) * kstep; const char* b2 = last ? nB : cB + (size_t)(t + 2) * kstep;
            const char* a3 = a2 + kstep; const char* b3 = b2 + kstep;
            if (last && has_next) S.a_ready(nxt);
            if constexpr (SP2) {
            PG8_LDB(B0, 0, 0); PG8_LDB(B1, 0, 1); PG8_SCHED; PG8_LDA(At, 0, 0); PG8_STAGE(PG8_SA(1, 1), a1 + hstep, voffA);
            PG8_WAIT_V(8); PG8_WAIT_L(0); PG8_BAR; PG8_MMA(0, 0, At, B0); PG8_MMA(0, 1, At, B1); PG8_BAR; PG8_SCHED;
            PG8_LDA(At, 0, 1); PG8_STAGE(PG8_SB(0, 0), b2, voffB); PG8_STAGE(PG8_SB(0, 1), b2 + hstep, voffB); PG8_STAGE(PG8_SA(0, 0), a2, voffA);
            PG8_WAIT_V(8); PG8_WAIT_L(0); PG8_BAR; PG8_MMA(1, 0, At, B0); PG8_MMA(1, 1, At, B1); PG8_BAR; PG8_SCHED;
            PG8_LDB(B0, 1, 0); PG8_LDB(B1, 1, 1); PG8_SCHED; PG8_LDA(At, 1, 0); PG8_STAGE(PG8_SA(0, 1), a2 + hstep, voffA);
            PG8_WAIT_V(8); PG8_WAIT_L(0); PG8_BAR; PG8_MMA(0, 0, At, B0); PG8_MMA(0, 1, At, B1); PG8_BAR; PG8_SCHED;
            PG8_LDA(At, 1, 1); PG8_STAGE(PG8_SB(1, 0), b3, voffB); PG8_STAGE(PG8_SB(1, 1), b3 + hstep, voffB); PG8_STAGE(PG8_SA(1, 0), a3, voffA);
            PG8_WAIT_V(8); PG8_WAIT_L(0); PG8_BAR; PG8_MMA(1, 0, At, B0); PG8_MMA(1, 1, At, B1); PG8_BAR; PG8_SCHED;
            } else {
            PG8_LDB(B0, 0, 0); PG8_SCHED; PG8_LDA(At, 0, 0); PG8_STAGE(PG8_SA(1, 1), a1 + hstep, voffA);
            PG8_WAIT_L(8); PG8_BAR; PG8_WAIT_L(0); PG8_MMA(0, 0, At, B0); PG8_BAR; PG8_SCHED;
            PG8_LDB(B1, 0, 1); PG8_STAGE(PG8_SB(0, 0), b2, voffB);
            PG8_BAR; PG8_WAIT_L(0); PG8_MMA(0, 1, At, B1); PG8_BAR;
            PG8_LDA(At, 0, 1); PG8_STAGE(PG8_SA(0, 0), a2, voffA);
            PG8_BAR; PG8_WAIT_L(0); PG8_MMA(1, 0, At, B0); PG8_BAR; PG8_SCHED;
            PG8_STAGE(PG8_SB(0, 1), b2 + hstep, voffB);
            PG8_WAIT_V(6); PG8_BAR; PG8_MMA(1, 1, At, B1); PG8_BAR;
            PG8_LDB(B0, 1, 0); PG8_SCHED; PG8_LDA(At, 1, 0); PG8_STAGE(PG8_SA(0, 1), a2 + hstep, voffA);
            PG8_WAIT_L(8); PG8_BAR; PG8_WAIT_L(0); PG8_MMA(0, 0, At, B0); PG8_BAR; PG8_SCHED;
            PG8_LDB(B1, 1, 1); PG8_STAGE(PG8_SB(1, 0), b3, voffB);
            PG8_BAR; PG8_WAIT_L(0); PG8_MMA(0, 1, At, B1); PG8_BAR;
            PG8_LDA(At, 1, 1); PG8_STAGE(PG8_SA(1, 0), a3, voffA);
            PG8_BAR; PG8_WAIT_L(0); PG8_MMA(1, 0, At, B0); PG8_BAR; PG8_SCHED;
            PG8_STAGE(PG8_SB(1, 1), b3 + hstep, voffB);
            PG8_WAIT_V(6); PG8_BAR; PG8_MMA(1, 1, At, B1); PG8_BAR;
            }
        }
        if constexpr (ALIGN_EPI) { if (wr == 0) PG8_BAR; }
        if constexpr (!Epi::AFTER_DRAIN) { E(acc, cur, wr, wc, fr, fq); S.done(cur); }
        if (!has_next) break;
#pragma unroll
        for (int a = 0; a < 2; ++a)
#pragma unroll
            for (int b = 0; b < 2; ++b)
#pragma unroll
                for (int m = 0; m < 4; ++m)
#pragma unroll
                    for (int n = 0; n < 2; ++n) acc[a][b][m][n] = (f32x4){0.f, 0.f, 0.f, 0.f};
        cur = nxt; cA = nA; cB = nB; ++ui;
        if constexpr (ALIGN_EPI) { if (wr == 1) PG8_BAR; }
    }
    PG8_WAIT_V(0);
    if constexpr (!ALIGN_EPI) { if (wr == 0) PG8_BAR; }
    PG8_BAR;
    if constexpr (Epi::AFTER_DRAIN) { E.fused(acc, cur, wr, wc, fr, fq, lds, wid, lane); S.done(cur); }
#undef PG8_SA
#undef PG8_SB
#undef PG8_STAGE
#undef PG8_LDA
#undef PG8_LDB
#undef PG8_MMA
#undef PG8_WAIT_V
#undef PG8_WAIT_L
#undef PG8_BAR
#undef PG8_SCHED
}
}
#define GAS __attribute__((address_space(1)))
#define LAS __attribute__((address_space(3)))
typedef unsigned short bf16;
typedef unsigned v4u __attribute__((ext_vector_type(4)));
typedef float f32x4 __attribute__((ext_vector_type(4)));
typedef short bf16x8 __attribute__((ext_vector_type(8)));
typedef GAS unsigned gu32;
typedef GAS unsigned long long gu64;
#define RLX_AGENT __ATOMIC_RELAXED, __HIP_MEMORY_SCOPE_AGENT
#define LDS_WAIT() asm volatile("s_waitcnt lgkmcnt(0)" ::: "memory")
#define VM_WAIT() asm volatile("s_waitcnt vmcnt(0)" ::: "memory")
__device__ __forceinline__ unsigned long long rt() { return __builtin_amdgcn_s_memrealtime(); }
__device__ __forceinline__ unsigned f2bf(float f) { unsigned u = __builtin_bit_cast(unsigned, f); return (u + 0x7fffu + ((u >> 16) & 1u)) >> 16; }
__device__ __forceinline__ unsigned pk2(float lo, float hi) { return f2bf(lo) | (f2bf(hi) << 16); }

#define XB_TMO      128
#define XB_XCNT(j)  (256  + 64 * (j))
#define XB_XSUB(j)  (1280 + 64 * (j))
#define XB_XGEN(j)  (2304 + 64 * (j))
#define XB_TOP      3328
#define XB_TOPGEN   3392
#define XCD_BAR_WORDS 3456
#define XB_SPIN_CAP (1u << 18)

__device__ __forceinline__ unsigned xb_ld(unsigned* p)              { return __hip_atomic_load(p, __ATOMIC_RELAXED, __HIP_MEMORY_SCOPE_AGENT); }
__device__ __forceinline__ unsigned xb_add(unsigned* p, unsigned v) { return __hip_atomic_fetch_add(p, v, __ATOMIC_RELAXED, __HIP_MEMORY_SCOPE_AGENT); }
__device__ __forceinline__ unsigned xb_xcc_id() { return (unsigned)__builtin_amdgcn_s_getreg((3 << 11) | 20) & 0xFu; }
#define XB_SPIN(cond, bar) do { unsigned _sp = 0; while (cond) { __builtin_amdgcn_s_sleep(1); \
    if ((++_sp & 255u) == 0u) { if (xb_ld(&(bar)[XB_TMO])) break; if (_sp > XB_SPIN_CAP) { atomicAdd(&(bar)[XB_TMO], 1u); break; } } } } while (0)

struct XcdBarrier {
    unsigned* bar; unsigned x;
    volatile LAS unsigned* st;
};

__device__ __forceinline__ XcdBarrier xcd_barrier_post(unsigned* bar, volatile LAS unsigned* st) {
    XcdBarrier b; b.bar = bar; b.x = xb_xcc_id(); b.st = st;
    if (threadIdx.x == 0) (void)xb_add(&bar[XB_XCNT(b.x)], 1u);
    return b;
}
__device__ __forceinline__ void xcd_barrier_complete(unsigned* bar, unsigned x, unsigned& nloc, unsigned& nx) {
    const unsigned G = gridDim.x * gridDim.y * gridDim.z;
    unsigned sum, cnt, mine, sp = 0u;
    for (;;) {
        sum = 0u; cnt = 0u; mine = 0u;
#pragma unroll
        for (unsigned j = 0; j < 16; ++j) { const unsigned c = xb_ld(&bar[XB_XCNT(j)]); sum += c; cnt += (c > 0u) ? 1u : 0u; mine = (j == x) ? c : mine; }
        if (sum == G) break;
        __builtin_amdgcn_s_sleep(1);
        if ((++sp & 255u) == 0u) { if (xb_ld(&bar[XB_TMO])) break; if (sp > XB_SPIN_CAP) { atomicAdd(&bar[XB_TMO], 1u); break; } }
    }
    nloc = mine > 0u ? mine : 1u; nx = cnt > 0u ? cnt : 1u;
}

__device__ __forceinline__ void xcd_barrier(const XcdBarrier& b) {
    asm volatile("s_waitcnt vmcnt(0)" ::: "memory");
    __syncthreads();
    if (threadIdx.x == 0) {
        unsigned* bar = b.bar;
        __builtin_amdgcn_s_waitcnt(0);
        unsigned nloc = b.st[0], nx = b.st[1];
        if (nloc == 0u) { xcd_barrier_complete(bar, b.x, nloc, nx); b.st[0] = nloc; b.st[1] = nx; }
        const unsigned old = xb_add(&bar[XB_XSUB(b.x)], 1u);
        const unsigned gen = old / nloc;
        if (old + 1u == (gen + 1u) * nloc) {
            __builtin_amdgcn_fence(__ATOMIC_RELEASE, "agent");
            asm volatile("s_waitcnt vmcnt(0)" ::: "memory");
            const unsigned og = xb_add(&bar[XB_TOP], 1u);
            const unsigned tg = og / nx;
            if (og + 1u == (tg + 1u) * nx) xb_add(&bar[XB_TOPGEN], 1u);
            else XB_SPIN(xb_ld(&bar[XB_TOPGEN]) == tg, bar);
            __builtin_amdgcn_fence(__ATOMIC_ACQUIRE, "agent");
            xb_add(&bar[XB_XGEN(b.x)], 1u);
            asm volatile("s_waitcnt vmcnt(0)" ::: "memory");
        } else {
            XB_SPIN(xb_ld(&bar[XB_XGEN(b.x)]) == gen, bar);
            __builtin_amdgcn_fence(__ATOMIC_ACQUIRE, "agent");
            asm volatile("s_waitcnt vmcnt(0)" ::: "memory");
        }
    }
    __syncthreads();
}

#if ONE_LAUNCH
#define GRID_SYNC() cooperative_groups::this_grid().sync()
#else
#define GRID_SYNC() do {} while (0)
#endif

constexpr int BATCH = 8, SEQ = 4096, DM = 1024, T = BATCH * SEQ;
constexpr int D_IN = 3584, D_MIX = 1536, D_Q = 2048;
constexpr int LCH = 64, NCHUNK = SEQ / LCH;
constexpr float LN_EPS = 1e-5f, RMS_EPS = 1e-6f;
constexpr float ALPHA = 1.189207115002721f;
constexpr int NWAVES = 8, NTHREADS = 512;

constexpr size_t MiB = 1u << 20;
constexpr size_t WS_CTL = 0, CTL_ZERO_BYTES = 64 * 1024;
constexpr size_t WS_WIN = 1 * MiB;
constexpr size_t WS_WOUT = 8 * MiB;
constexpr size_t WS_WQ = 11 * MiB;
constexpr size_t WS_GW = 15 * MiB;
constexpr size_t WS_K1 = 16 * MiB;
constexpr size_t WS_K2 = 16 * MiB + 64 * 1024;
constexpr size_t WS_CARRY = 18 * MiB;
constexpr size_t WS_SUMM = 24 * MiB;
constexpr size_t WS_H0 = 32 * MiB;
constexpr size_t WS_H1 = 32 * MiB;
constexpr size_t WS_XR = 96 * MiB;
constexpr size_t WS_PRE1 = 96 * MiB;
constexpr size_t WS_GATE = 160 * MiB;
constexpr size_t WS_CCX = 224 * MiB;
constexpr size_t WS_U8 = 416 * MiB;
constexpr size_t WS_V8 = 432 * MiB;
#ifndef TABLE_FP4
#define TABLE_FP4 1
#endif
#if TABLE_FP4
constexpr float U_SCALE = 64.f, V_SCALE = 3.3635857f;
constexpr float U_STEP = 0.3352f / 32.f;
constexpr int ROWB = 512;
#else
constexpr float U_SCALE = 256.f, V_SCALE = 16.f;
constexpr int ROWB = 1024;
#endif
constexpr size_t WS_MIX = 288 * MiB;
constexpr size_t WS_Q = 288 * MiB;
constexpr size_t WS_IDX = 448 * MiB;
constexpr size_t WS_G = 464 * MiB;
constexpr size_t WS_DOT = 480 * MiB;
constexpr size_t WS_END = 512 * MiB;

constexpr int LDS_BYTES = 147456;
constexpr int MISC_OFF = 143360;

typedef unsigned v2u __attribute__((ext_vector_type(2)));
typedef __bf16 bf16x2 __attribute__((ext_vector_type(2)));

typedef float f32x2_ __attribute__((ext_vector_type(2)));
__device__ __forceinline__ unsigned pk2h(float lo, float hi) { const f32x2_ v = {lo, hi}; const bf16x2 b = __builtin_convertvector(v, bf16x2); return __builtin_bit_cast(unsigned, b); }
#define pk2(lo, hi) pk2h((lo), (hi))
#define f2bf(x) (pk2h((x), 0.f) & 0xffffu)
__device__ __forceinline__ float bflo(unsigned w) { return __builtin_bit_cast(float, w << 16); }
__device__ __forceinline__ float bfhi(unsigned w) { return __builtin_bit_cast(float, w & 0xffff0000u); }
__device__ __forceinline__ float wave_sum(float v) {
#pragma unroll
    for (int o = 1; o < 64; o <<= 1) v += __shfl_xor(v, o);
    return v;
}
__device__ __forceinline__ float dot2_bf16(unsigned w, unsigned x, float acc) { return __builtin_amdgcn_fdot2_f32_bf16(__builtin_bit_cast(bf16x2, w), __builtin_bit_cast(bf16x2, x), acc, false); }
__device__ __forceinline__ float sigmoidf_(float x) { return __builtin_amdgcn_rcpf(1.0f + __builtin_amdgcn_exp2f(-1.4426950408889634f * x)); }
__device__ __forceinline__ float gelu_tanh(float x) { const float u = 0.7978845608028654f * (x + 0.044715f * x * x * x); return 0.5f * x * (1.0f + tanhf(u)); }
__device__ __forceinline__ float gelu_erf(float x) { return 0.5f * x * (1.0f + erff(x * 0.7071067811865476f)); }

struct Args { const float* in[24]; float* out; unsigned char* ws; int ph_lo, ph_hi; };

template <bool REMAP = false>
__device__ __forceinline__ void p0_transpose_item(const float* W, int K, int N, bf16* WT, LAS float* scr, int item, int lane, float wscale = 1.0f) {
    const int nblk = N / 32, kb = item / nblk, nb = item % nblk, k0 = 64 * kb, n0 = 32 * nb;
    int ns = n0;
    if (REMAP && n0 >= 2560) { const int j = (n0 - 2560) >> 8, w = (n0 - 2560) & 255; ns = (w < 128) ? 2560 + 128 * j + w : 3072 + 128 * j + (w - 128); }
#pragma unroll 8
    for (int i = 0; i < 32; ++i) { const int kk = 2 * i + (lane >> 5); scr[kk * 33 + (lane & 31)] = wscale * W[(size_t)(k0 + kk) * N + ns + (lane & 31)]; }
    asm volatile("s_waitcnt lgkmcnt(0)" ::: "memory");
    const int c = lane & 7;
#pragma unroll
    for (int j = 0; j < 4; ++j) { const int n = (lane >> 3) + 8 * j; const LAS float* s = scr + (8 * c) * 33 + n;
        v4u o; o.x = pk2(s[0 * 33], s[1 * 33]); o.y = pk2(s[2 * 33], s[3 * 33]); o.z = pk2(s[4 * 33], s[5 * 33]); o.w = pk2(s[6 * 33], s[7 * 33]);
        ST16_WT(WT + (size_t)(n0 + n) * K + k0 + 8 * c, o); }
    asm volatile("s_waitcnt lgkmcnt(0)" ::: "memory");
}
__device__ __forceinline__ void ln_row_bf16(const float* xrow, const float* g, const float* b, bf16* orow, int lane) {
    f32x4 v[4]; float s = 0.f;
#pragma unroll
    for (int j = 0; j < 2; ++j) { v[2 * j] = *(const f32x4*)(xrow + 512 * j + 8 * lane); v[2 * j + 1] = *(const f32x4*)(xrow + 512 * j + 8 * lane + 4); }
#pragma unroll
    for (int j = 0; j < 4; ++j) s += (v[j].x + v[j].y) + (v[j].z + v[j].w);
    const float mean = wave_sum(s) * (1.f / DM); float s2 = 0.f;
#pragma unroll
    for (int j = 0; j < 4; ++j) { v[j] = v[j] - mean; s2 += (v[j].x * v[j].x + v[j].y * v[j].y) + (v[j].z * v[j].z + v[j].w * v[j].w); }
    const float rstd = __builtin_amdgcn_rsqf(wave_sum(s2) * (1.f / DM) + LN_EPS);
#pragma unroll
    for (int j = 0; j < 2; ++j) { const int col = 512 * j + 8 * lane;
        const f32x4 g0 = *(const f32x4*)(g + col), g1 = *(const f32x4*)(g + col + 4), b0 = *(const f32x4*)(b + col), b1 = *(const f32x4*)(b + col + 4);
        const f32x4 o0 = v[2 * j] * rstd * g0 + b0, o1 = v[2 * j + 1] * rstd * g1 + b1;
        v4u w; w.x = pk2(o0.x, o0.y); w.y = pk2(o0.z, o0.w); w.z = pk2(o1.x, o1.y); w.w = pk2(o1.z, o1.w);
        ST16_WT(orow + col, w); }
}
__device__ __forceinline__ void ln_row_bf16_b(const bf16* xrow, const float* g, const float* b, bf16* orow, int lane) {
    const v4u a0 = *(const v4u*)(xrow + 8 * lane), a1 = *(const v4u*)(xrow + 512 + 8 * lane);
    float v[16]; float s = 0.f;
#pragma unroll
    for (int i = 0; i < 4; ++i) { v[2 * i] = bflo(a0[i]); v[2 * i + 1] = bfhi(a0[i]); v[8 + 2 * i] = bflo(a1[i]); v[8 + 2 * i + 1] = bfhi(a1[i]); }
#pragma unroll
    for (int i = 0; i < 16; ++i) s += v[i];
    const float mean = wave_sum(s) * (1.f / DM); float s2 = 0.f;
#pragma unroll
    for (int i = 0; i < 16; ++i) { v[i] -= mean; s2 += v[i] * v[i]; }
    const float rstd = __builtin_amdgcn_rsqf(wave_sum(s2) * (1.f / DM) + LN_EPS);
#pragma unroll
    for (int hf = 0; hf < 2; ++hf) { const int col = hf * 512 + 8 * lane; const f32x4 g0 = *(const f32x4*)(g + col), g1 = *(const f32x4*)(g + col + 4), b0 = *(const f32x4*)(b + col), b1 = *(const f32x4*)(b + col + 4);
        v4u o; o.x = pk2(v[hf * 8 + 0] * rstd * g0[0] + b0[0], v[hf * 8 + 1] * rstd * g0[1] + b0[1]); o.y = pk2(v[hf * 8 + 2] * rstd * g0[2] + b0[2], v[hf * 8 + 3] * rstd * g0[3] + b0[3]);
        o.z = pk2(v[hf * 8 + 4] * rstd * g1[0] + b1[0], v[hf * 8 + 5] * rstd * g1[1] + b1[1]); o.w = pk2(v[hf * 8 + 6] * rstd * g1[2] + b1[2], v[hf * 8 + 7] * rstd * g1[3] + b1[3]);
        ST16_WT(orow + col, o); }
}
__device__ __forceinline__ void ln_rows_f32(const float* X, const float* g, const float* b, bf16* O, int gw, int NGW, int lane) {
    const __amdgpu_buffer_rsrc_t ors = __builtin_amdgcn_make_buffer_rsrc((void*)O, 0, (int)((size_t)T * DM * 2), 0x00020000);
    f32x4 gg[4], bb[4];
#pragma unroll
    for (int j = 0; j < 2; ++j) { const int col = 512 * j + 8 * lane; gg[2 * j] = *(const f32x4*)(g + col); gg[2 * j + 1] = *(const f32x4*)(g + col + 4); bb[2 * j] = *(const f32x4*)(b + col); bb[2 * j + 1] = *(const f32x4*)(b + col + 4); }
    auto ld = [&](f32x4 (&v)[4], int m) { const float* xr = X + (size_t)min(m, T - 1) * DM;
#pragma unroll
        for (int j = 0; j < 2; ++j) { v[2 * j] = *(const f32x4*)(xr + 512 * j + 8 * lane); v[2 * j + 1] = *(const f32x4*)(xr + 512 * j + 8 * lane + 4); } };
    auto fin = [&](f32x4 (&v)[4], int m) { const int mr = min(m, T - 1); float s = 0.f;
#pragma unroll
        for (int j = 0; j < 4; ++j) s += (v[j].x + v[j].y) + (v[j].z + v[j].w);
        const float mean = wave_sum(s) * (1.f / DM); float s2 = 0.f;
#pragma unroll
        for (int j = 0; j < 4; ++j) { v[j] = v[j] - mean; s2 += (v[j].x * v[j].x + v[j].y * v[j].y) + (v[j].z * v[j].z + v[j].w * v[j].w); }
        const float rstd = __builtin_amdgcn_rsqf(wave_sum(s2) * (1.f / DM) + LN_EPS);
#pragma unroll
        for (int j = 0; j < 2; ++j) { const f32x4 o0 = v[2 * j] * rstd * gg[2 * j] + bb[2 * j], o1 = v[2 * j + 1] * rstd * gg[2 * j + 1] + bb[2 * j + 1];
            v4u w; w.x = pk2(o0.x, o0.y); w.y = pk2(o0.z, o0.w); w.z = pk2(o1.x, o1.y); w.w = pk2(o1.z, o1.w);
            ST16_WTB(ors, (mr * DM + 512 * j + 8 * lane) * 2, w); } };
    f32x4 r0[4], r1[4], r2[4];
    int m = gw; ld(r0, m); ld(r1, m + NGW);
#define SB_ __builtin_amdgcn_sched_barrier(0)
    SB_;
    for (; m < T; m += 3 * NGW) { ld(r2, m + 2 * NGW); SB_; fin(r0, m); SB_; ld(r0, m + 3 * NGW); SB_; fin(r1, m + NGW); SB_; ld(r1, m + 4 * NGW); SB_; fin(r2, m + 2 * NGW); SB_; }
}
__device__ __forceinline__ void ln_rows_bf16(const bf16* X, const float* g, const float* b, bf16* O, int gw, int NGW, int lane) {
    const __amdgpu_buffer_rsrc_t ors = __builtin_amdgcn_make_buffer_rsrc((void*)O, 0, (int)((size_t)T * DM * 2), 0x00020000);
    f32x4 gg[4], bb[4];
#pragma unroll
    for (int j = 0; j < 2; ++j) { const int col = 512 * j + 8 * lane; gg[2 * j] = *(const f32x4*)(g + col); gg[2 * j + 1] = *(const f32x4*)(g + col + 4); bb[2 * j] = *(const f32x4*)(b + col); bb[2 * j + 1] = *(const f32x4*)(b + col + 4); }
    struct Row { v4u a0, a1; };
    auto ld = [&](Row& r, int m) { const bf16* xr = X + (size_t)min(m, T - 1) * DM; r.a0 = *(const v4u*)(xr + 8 * lane); r.a1 = *(const v4u*)(xr + 512 + 8 * lane); };
    auto fin = [&](const Row& r, int m) { const int mr = min(m, T - 1); float v[16]; float s = 0.f;
#pragma unroll
        for (int i = 0; i < 4; ++i) { v[2 * i] = bflo(r.a0[i]); v[2 * i + 1] = bfhi(r.a0[i]); v[8 + 2 * i] = bflo(r.a1[i]); v[8 + 2 * i + 1] = bfhi(r.a1[i]); }
#pragma unroll
        for (int i = 0; i < 16; ++i) s += v[i];
        const float mean = wave_sum(s) * (1.f / DM); float s2 = 0.f;
#pragma unroll
        for (int i = 0; i < 16; ++i) { v[i] -= mean; s2 += v[i] * v[i]; }
        const float rstd = __builtin_amdgcn_rsqf(wave_sum(s2) * (1.f / DM) + LN_EPS);
#pragma unroll
        for (int hf = 0; hf < 2; ++hf) { const f32x4 g0 = gg[2 * hf], g1 = gg[2 * hf + 1], b0 = bb[2 * hf], b1 = bb[2 * hf + 1];
            v4u o; o.x = pk2(v[hf * 8 + 0] * rstd * g0[0] + b0[0], v[hf * 8 + 1] * rstd * g0[1] + b0[1]); o.y = pk2(v[hf * 8 + 2] * rstd * g0[2] + b0[2], v[hf * 8 + 3] * rstd * g0[3] + b0[3]);
            o.z = pk2(v[hf * 8 + 4] * rstd * g1[0] + b1[0], v[hf * 8 + 5] * rstd * g1[1] + b1[1]); o.w = pk2(v[hf * 8 + 6] * rstd * g1[2] + b1[2], v[hf * 8 + 7] * rstd * g1[3] + b1[3]);
            ST16_WTB(ors, (mr * DM + hf * 512 + 8 * lane) * 2, o); } };
    Row r0, r1, r2, r3;
    int m = gw; ld(r0, m); ld(r1, m + NGW); ld(r2, m + 2 * NGW);
    SB_;
    for (; m < T; m += 4 * NGW) { ld(r3, m + 3 * NGW); SB_; fin(r0, m); SB_; ld(r0, m + 4 * NGW); SB_; fin(r1, m + NGW); SB_; ld(r1, m + 5 * NGW); SB_; fin(r2, m + 2 * NGW); SB_; ld(r2, m + 6 * NGW); SB_; fin(r3, m + 3 * NGW); SB_; }
}
__device__ __forceinline__ void phase0(const Args& a, LAS unsigned char* lds, int vcu, int G, int wave, int lane) {
    unsigned char* ws = a.ws;
    LAS float* scr = (LAS float*)(lds + wave * 16384);
    const int gw = vcu * NWAVES + wave, NGW = G * NWAVES;
    constexpr int I_IN = (DM / 64) * (D_IN / 32), I_OUT = (D_MIX / 64) * (DM / 32), I_Q = (DM / 64) * (D_Q / 32), I_G = 32 * 8;
    constexpr int NITEMS = I_IN + I_OUT + I_Q + I_G;
    for (int it = gw; it < NITEMS; it += NGW) {
        int r = it;
        if (r < I_IN) { p0_transpose_item<true>(a.in[3], DM, D_IN, (bf16*)(ws + WS_WIN), scr, r, lane); continue; } r -= I_IN;
        if (r < I_OUT) { p0_transpose_item(a.in[14], D_MIX, DM, (bf16*)(ws + WS_WOUT), scr, r, lane); continue; } r -= I_OUT;
        if (r < I_Q) { p0_transpose_item(a.in[17], DM, D_Q, (bf16*)(ws + WS_WQ), scr, r, lane); continue; } r -= I_Q;
        { const int blk = r >> 3, sub = r & 7;
          const int d = blk >> 4, which = (blk >> 3) & 1, h = blk & 7;
          const float* W = (which ? a.in[8] : a.in[6]) + (size_t)(d * 8 + h) * 16384;
          p0_transpose_item(W, 128, 128, (bf16*)(ws + WS_GW) + (size_t)blk * 16384, scr, sub, lane, -1.4426950408889634f); }
    }
    { const int gt = gw * 64 + lane, NGT = NGW * 64;
      for (int i = gt; i < 2 * 16384; i += NGT) { const float v = (i < 16384) ? a.in[18][i] : a.in[19][i - 16384]; bf16* dst = (i < 16384) ? (bf16*)(ws + WS_K1) + i : (bf16*)(ws + WS_K2) + (i - 16384); *dst = (bf16)f2bf(v); } }
    ln_rows_f32(a.in[0], a.in[1], a.in[2], (bf16*)(ws + WS_H0), gw, NGW, lane);
}

struct EpiIn {
    static constexpr bool PERM = true, AFTER_DRAIN = false;
    bf16 *XR, *GATE, *MIX, *CCX;
    __device__ __forceinline__ void operator()(const pg8::f32x4 (&acc)[2][2][4][2], const pg8::Unit& u, int wr, int wc, int fr, int fq) const {
        const int row0 = u.pm * 256 + wr * 64 + fr; const int pn = u.pn;
        bf16* base; int ldc, colt;
        if (pn < 4) { base = XR; ldc = 1024; colt = pn * 256; }
        else if (pn < 8) { base = GATE; ldc = 1024; colt = (pn - 4) * 256; }
        else if (pn < 10) { base = MIX; ldc = 1536; colt = 1024 + (pn - 8) * 256; }
        else {
            const int cc0 = (pn - 10) * 128 + wc * 32 + 8 * fq;
#pragma unroll
            for (int ai = 0; ai < 2; ++ai)
#pragma unroll
                for (int m = 0; m < 4; ++m) { const pg8::f32x4 p0 = acc[ai][0][m][0] * acc[ai][1][m][0], p1 = acc[ai][0][m][1] * acc[ai][1][m][1];
                    pg8::u32x4 w; w.x = pg8::cvt_pk_bf16(p0[0], p0[1]); w.y = pg8::cvt_pk_bf16(p0[2], p0[3]); w.z = pg8::cvt_pk_bf16(p1[0], p1[1]); w.w = pg8::cvt_pk_bf16(p1[2], p1[3]);
                    ST16_WT(CCX + (size_t)(row0 + ai * 128 + m * 16) * 512 + cc0, w); }
            return; }
        const int col0 = colt + wc * 32 + 8 * fq;
#pragma unroll
        for (int ai = 0; ai < 2; ++ai)
#pragma unroll
            for (int m = 0; m < 4; ++m) { bf16* rowp = base + (size_t)(row0 + ai * 128 + m * 16) * ldc + col0;
#pragma unroll
                for (int bj = 0; bj < 2; ++bj) { const pg8::f32x4 v0 = acc[ai][bj][m][0], v1 = acc[ai][bj][m][1];
                    pg8::u32x4 w; w.x = pg8::cvt_pk_bf16(v0[0], v0[1]); w.y = pg8::cvt_pk_bf16(v0[2], v0[3]); w.z = pg8::cvt_pk_bf16(v1[0], v1[1]); w.w = pg8::cvt_pk_bf16(v1[2], v1[3]);
                    ST16_WT(rowp + bj * 128, w); } }
    }
};
struct EpiPre {
    static constexpr bool PERM = true, AFTER_DRAIN = false;
    const bf16* H0; bf16* PRE;
    __device__ __forceinline__ void operator()(const pg8::f32x4 (&acc)[2][2][4][2], const pg8::Unit& u, int wr, int wc, int fr, int fq) const {
        const int row0 = u.pm * 256 + wr * 64 + fr, col0 = u.pn * 256 + wc * 32 + 8 * fq;
#pragma unroll
        for (int ai = 0; ai < 2; ++ai)
#pragma unroll
            for (int m = 0; m < 4; ++m) { const size_t ro = (size_t)(row0 + ai * 128 + m * 16) * DM + col0;
#pragma unroll
                for (int bj = 0; bj < 2; ++bj) { const v4u hw = *(const v4u*)(H0 + ro + bj * 128);
                    const pg8::f32x4 v0 = acc[ai][bj][m][0], v1 = acc[ai][bj][m][1];
                    v4u o; o.x = pk2(v0[0] + ALPHA * bflo(hw.x), v0[1] + ALPHA * bfhi(hw.x)); o.y = pk2(v0[2] + ALPHA * bflo(hw.y), v0[3] + ALPHA * bfhi(hw.y));
                    o.z = pk2(v1[0] + ALPHA * bflo(hw.z), v1[1] + ALPHA * bfhi(hw.z)); o.w = pk2(v1[2] + ALPHA * bflo(hw.w), v1[3] + ALPHA * bfhi(hw.w));
                    ST16_WT(PRE + ro + bj * 128, o); } }
    }
};

constexpr size_t TAB_GROUPS = (size_t)16384 * 1024 / 16;
#if TABLE_FP4
struct TabGroup { f32x4 v[4]; };
__device__ __forceinline__ void tab_load(TabGroup& g, const Args& a, size_t i) {
    const bool second = i >= TAB_GROUPS; const float* src = (second ? a.in[21] : a.in[20]) + (second ? i - TAB_GROUPS : i) * 16;
#pragma unroll
    for (int q = 0; q < 4; ++q) g.v[q] = *(const f32x4*)(src + 4 * q);
}
__device__ __forceinline__ void tab_store(const TabGroup& g, const Args& a, size_t i) {
    const bool second = i >= TAB_GROUPS; const size_t j = second ? i - TAB_GROUPS : i;
    unsigned char* dst = a.ws + (second ? WS_V8 : WS_U8) + j * 8;
    v2u o;
    if (second) {
#pragma unroll
        for (int q = 0; q < 2; ++q) { unsigned w = 0u; const f32x4 v0 = g.v[2 * q] * V_SCALE, v1 = g.v[2 * q + 1] * V_SCALE;
            w = __builtin_amdgcn_cvt_scalef32_pk_fp4_f32(w, fminf(fmaxf(v0[0], -6.f), 6.f), fminf(fmaxf(v0[1], -6.f), 6.f), 1.0f, 0);
            w = __builtin_amdgcn_cvt_scalef32_pk_fp4_f32(w, fminf(fmaxf(v0[2], -6.f), 6.f), fminf(fmaxf(v0[3], -6.f), 6.f), 1.0f, 1);
            w = __builtin_amdgcn_cvt_scalef32_pk_fp4_f32(w, fminf(fmaxf(v1[0], -6.f), 6.f), fminf(fmaxf(v1[1], -6.f), 6.f), 1.0f, 2);
            w = __builtin_amdgcn_cvt_scalef32_pk_fp4_f32(w, fminf(fmaxf(v1[2], -6.f), 6.f), fminf(fmaxf(v1[3], -6.f), 6.f), 1.0f, 3);
            o[q] = w; }
    } else {
#pragma unroll
        for (int q = 0; q < 2; ++q) { unsigned w = 0u;
#pragma unroll
            for (int e = 0; e < 8; ++e) { const float fv = floorf(g.v[2 * q + (e >> 2)][e & 3] * (1.0f / U_STEP)); const int qi = (int)fminf(fmaxf(fv, -8.f), 7.f); w |= ((unsigned)qi & 15u) << (4 * e); }
            o[q] = w; }
    }
    *(v2u*)dst = o;
}
#endif
#ifndef P2_EARLY1
#define P2_EARLY1 1
#endif
constexpr int ST_PITCH = 272;
constexpr int ST_TILE = 64 * ST_PITCH;
constexpr int A8_PITCH = 144, A8_TILE = 64 * A8_PITCH;
constexpr int P2_XRT = 0, P2_XC = 18432  , P2_STA = 55296  , P2_STS = P2_STA + 2 * A8_TILE;
constexpr int P2_XRT2 = P2_STS + ST_TILE;
static_assert(P2_XRT2 + 70 * 256 <= 143360, "P2 LDS");
constexpr int XC_PITCH = 272;
struct P2Const { float w0[4], w1[4], b0, b1, bav, bxv, sp; };
__device__ __forceinline__ void p2_load_const(P2Const& k, const Args& a, int d, int h, int tid, int wave, int lane) {
    const int gch2 = h * 128 + 2 * (tid & 63);
#pragma unroll
    for (int t = 0; t < 4; ++t) { k.w0[t] = a.in[4][(d * 4 + t) * DM + gch2]; k.w1[t] = a.in[4][(d * 4 + t) * DM + gch2 + 1]; }
    k.b0 = a.in[5][d * DM + gch2]; k.b1 = a.in[5][d * DM + gch2 + 1];
    const int gch = h * 128 + 16 * wave + (lane & 15);
    k.bav = -1.4426950408889634f * a.in[7][d * DM + gch]; k.bxv = -1.4426950408889634f * a.in[9][d * DM + gch];
    k.sp = -8.0f * 1.4426950408889634f * log1pf(__expf(-a.in[10][d * DM + gch]));
}
template <int D>
__device__ __forceinline__ void p2_conv(const P2Const& k, LAS unsigned char* lds, const LAS unsigned char* XRT, int tid) {
    LAS unsigned char* XC = lds + P2_XC + D * 18432;
    { const int ch2 = tid & 63, tq = tid >> 6; const int rbase = tq * 8 + (D ? 3 : 0);
      unsigned xw[11];
#pragma unroll
      for (int i = 0; i < 11; ++i) xw[i] = *(const LAS unsigned*)(XRT + (rbase + i) * 256 + ch2 * 4);
#pragma unroll
      for (int i = 0; i < 8; ++i) { float s0 = k.b0, s1 = k.b1;
#pragma unroll
          for (int t = 0; t < 4; ++t) { s0 += k.w0[t] * bflo(xw[i + t]); s1 += k.w1[t] * bfhi(xw[i + t]); }
          *(LAS unsigned*)(XC + (tq * 8 + i) * XC_PITCH + ch2 * 4) = pk2(s0, s1); } }
}
__device__ __forceinline__ void p2_load_bfrag(bf16x8 (&bA)[4], bf16x8 (&bX)[4], const bf16* GW, int d, int h, int wave, int lane) {
    const bf16* gwa = GW + (size_t)((d * 2 + 0) * 8 + h) * 16384 + (16 * wave + (lane & 15)) * 128 + 8 * (lane >> 4);
    const bf16* gwx = GW + (size_t)((d * 2 + 1) * 8 + h) * 16384 + (16 * wave + (lane & 15)) * 128 + 8 * (lane >> 4);
#pragma unroll
    for (int ks = 0; ks < 4; ++ks) { bA[ks] = *(const bf16x8*)(gwa + ks * 32); bX[ks] = *(const bf16x8*)(gwx + ks * 32); }
}
template <int D, class Mid>
__device__ __forceinline__ void p2_dir(const P2Const& k, LAS unsigned char* lds, float (&hf)[4][4],
                                       bf16x8 (&bA)[4], bf16x8 (&bX)[4], Mid&& mid, float& sum_p, float& sum_h, int wave, int lane) {
    LAS unsigned char* XC = lds + P2_XC + D * 18432; LAS unsigned char* STA = lds + P2_STA + D * A8_TILE; LAS unsigned char* STS = lds + P2_STS;
    const int q = lane >> 4, r = lane & 15, ch = 16 * wave + r;
    float av[4][4], uv[4][4];
    { pg8::f32x4 accr[4], acci[4];
#pragma unroll
      for (int m = 0; m < 4; ++m) { accr[m] = (pg8::f32x4){k.bav, k.bav, k.bav, k.bav}; acci[m] = (pg8::f32x4){k.bxv, k.bxv, k.bxv, k.bxv}; }
#pragma unroll
      for (int ks = 0; ks < 4; ++ks)
#pragma unroll
          for (int m = 0; m < 4; ++m) { const bf16x8 af = *(const LAS bf16x8*)(XC + (16 * m + r) * XC_PITCH + (ks * 32 + 8 * q) * 2);
              accr[m] = __builtin_amdgcn_mfma_f32_16x16x32_bf16(af, bA[ks], accr[m], 0, 0, 0);
              acci[m] = __builtin_amdgcn_mfma_f32_16x16x32_bf16(af, bX[ks], acci[m], 0, 0, 0); }
#pragma unroll
      for (int m = 0; m < 4; ++m)
#pragma unroll
          for (int j = 0; j < 4; ++j) { const int tt = 16 * m + 4 * q + j;
              const float ar = accr[m][j], ai = acci[m][j];
              const float rg = __builtin_amdgcn_rcpf(1.0f + __builtin_amdgcn_exp2f(ar)), ig = __builtin_amdgcn_rcpf(1.0f + __builtin_amdgcn_exp2f(ai));
              const float a_ = __builtin_amdgcn_exp2f(k.sp * rg);
              const float xcv = __uint_as_float((unsigned)(*(const LAS unsigned short*)(XC + tt * XC_PITCH + ch * 2)) << 16);
              const float om = fmaxf(1.0f - a_ * a_, 0.f);
              av[m][j] = a_; uv[m][j] = __builtin_amdgcn_sqrtf(om) * ig * xcv; } }
    __builtin_amdgcn_sched_barrier(0);
    mid();
    __builtin_amdgcn_sched_barrier(0);
    float Pt[4], Ht[4], Pe[4], He[4], PT[4], HT[4];
#pragma unroll
    for (int m = 0; m < 4; ++m) {
        if (D == 0) {
#pragma unroll
            for (int j = 1; j < 4; ++j) { uv[m][j] = av[m][j] * uv[m][j - 1] + uv[m][j]; av[m][j] = av[m][j] * av[m][j - 1]; }
        } else {
#pragma unroll
            for (int j = 2; j >= 0; --j) { uv[m][j] = av[m][j] * uv[m][j + 1] + uv[m][j]; av[m][j] = av[m][j] * av[m][j + 1]; }
        }
        Pt[m] = D ? av[m][0] : av[m][3]; Ht[m] = D ? uv[m][0] : uv[m][3];
    }
    { const int src = (D ? lane + 16 : lane - 16) & 63; const bool ok = D ? (q <= 2) : (q >= 1); float Pp[4], Hp[4];
#pragma unroll
      for (int m = 0; m < 4; ++m) { Pp[m] = __shfl(Pt[m], src); Hp[m] = __shfl(Ht[m], src); }
#pragma unroll
      for (int m = 0; m < 4; ++m) if (ok) { Ht[m] = Pt[m] * Hp[m] + Ht[m]; Pt[m] = Pt[m] * Pp[m]; } }
    { const int src = (D ? lane + 32 : lane - 32) & 63; const bool ok = D ? (q <= 1) : (q >= 2); float Pp[4], Hp[4];
#pragma unroll
      for (int m = 0; m < 4; ++m) { Pp[m] = __shfl(Pt[m], src); Hp[m] = __shfl(Ht[m], src); }
#pragma unroll
      for (int m = 0; m < 4; ++m) if (ok) { Ht[m] = Pt[m] * Hp[m] + Ht[m]; Pt[m] = Pt[m] * Pp[m]; } }
    { const int src = (D ? lane + 16 : lane - 16) & 63; const bool first = D ? (q == 3) : (q == 0); const int tl = D ? r : 48 + r;
#pragma unroll
      for (int m = 0; m < 4; ++m) { Pe[m] = __shfl(Pt[m], src); He[m] = __shfl(Ht[m], src); PT[m] = __shfl(Pt[m], tl); HT[m] = __shfl(Ht[m], tl); }
#pragma unroll
      for (int m = 0; m < 4; ++m) if (first) { Pe[m] = 1.f; He[m] = 0.f; } }
    float cp = 1.f, chh = 0.f;
#pragma unroll
    for (int mm = 0; mm < 4; ++mm) { const int m = D ? 3 - mm : mm;
        const float Ch = Pe[m] * chh + He[m], Cp = cp * Pe[m];
#pragma unroll
        for (int j = 0; j < 4; ++j) { uv[m][j] += av[m][j] * Ch; av[m][j] *= Cp; }
        chh = PT[m] * chh + HT[m]; cp *= PT[m];
    }
    sum_p = cp; sum_h = chh;
#pragma unroll
    for (int m = 0; m < 4; ++m)
#pragma unroll
        for (int j = 0; j < 4; ++j) { const int tt = 16 * m + 4 * q + j;
            *(LAS unsigned char*)(STA + tt * A8_PITCH + ch) = (unsigned char)(unsigned)(av[m][j] * 255.f + 0.5f);
            if (D == 0) hf[m][j] = uv[m][j]; else *(LAS unsigned short*)(STS + tt * ST_PITCH + ch * 2) = (unsigned short)f2bf(hf[m][j] + uv[m][j]); }
}
__device__ __forceinline__ void phase2(const Args& a, LAS unsigned char* lds, int vcu, int G, int tid, int wave, int lane) {
    unsigned char* ws = a.ws;
    const bf16* XR = (const bf16*)(ws + WS_XR); const bf16* GW = (const bf16*)(ws + WS_GW);
    unsigned char* AF8 = (unsigned char*)a.out; unsigned char* AB8 = AF8 + (size_t)T * DM; bf16* MIX = (bf16*)(ws + WS_MIX);
    float* SUMM = (float*)(ws + WS_SUMM);
    P2Const k0, k1; int hcur = -1;
    const int NIT = BATCH * NCHUNK * 8;
    v4u pre[3];
    auto fetch = [&](int it) { const int h = it & 7, c = (it >> 3) & 63, b = it >> 9; const int t0 = c * LCH; const size_t rowb = (size_t)b * SEQ;
#pragma unroll
        for (int i = 0; i < 3; ++i) { const int q = min(tid + i * NTHREADS, 70 * 16 - 1); const int r = q >> 4, cc = q & 15; const int t = min(max(t0 - 3 + r, 0), SEQ - 1);
            pre[i] = *(const v4u*)(XR + (rowb + t) * DM + h * 128 + cc * 8); } };
    auto put = [&](int it, LAS unsigned char* dst) { const int t0 = ((it >> 3) & 63) * LCH;
#pragma unroll
        for (int i = 0; i < 3; ++i) { const int q = tid + i * NTHREADS; const int t = t0 - 3 + (q >> 4); const bool ok = t >= 0 && t < SEQ;
            const v4u w = ok ? pre[i] : (v4u){0u, 0u, 0u, 0u};
            if (q < 70 * 16) *(LAS v4u*)(dst + (q >> 4) * 256 + (q & 15) * 16) = w; } };
    bf16x8 fA0[4], fX0[4], fA1[4], fX1[4];
    auto pin0 = [&]() {
#pragma unroll
        for (int ks = 0; ks < 4; ++ks) asm volatile("" : "+v"(fA0[ks]), "+v"(fX0[ks])); };
    if (vcu < NIT) { fetch(vcu); put(vcu, lds + P2_XRT); p2_load_bfrag(fA0, fX0, GW, 0, vcu & 7, wave, lane); pin0(); }
    __syncthreads();
    int par = 0;
    for (int it = vcu; it < NIT; it += G, par ^= 1) {
        const int h = it & 7, c = (it >> 3) & 63, b = it >> 9;
        const int t0 = c * LCH; const size_t rowb = (size_t)b * SEQ;
        if (h != hcur) { p2_load_const(k0, a, 0, h, tid, wave, lane); p2_load_const(k1, a, 1, h, tid, wave, lane); hcur = h;
#pragma unroll
            for (int t = 0; t < 4; ++t) asm volatile("" : "+v"(k0.w0[t]), "+v"(k0.w1[t]), "+v"(k1.w0[t]), "+v"(k1.w1[t]));
            asm volatile("" : "+v"(k0.b0), "+v"(k0.b1), "+v"(k1.b0), "+v"(k1.b1));
            asm volatile("" : "+v"(k0.bav), "+v"(k0.bxv), "+v"(k0.sp), "+v"(k1.bav), "+v"(k1.bxv), "+v"(k1.sp)); }
        const LAS unsigned char* XRT = lds + (par ? P2_XRT2 : P2_XRT); LAS unsigned char* XRTn = lds + (par ? P2_XRT : P2_XRT2);
        const bool has_next = it + G < NIT; const int itn = has_next ? it + G : it;
        p2_conv<0>(k0, lds, XRT, tid); p2_conv<1>(k1, lds, XRT, tid);
        __syncthreads();
        float hf[4][4], sp0, sh0, sp1, sh1;
        p2_dir<0>(k0, lds, hf, fA0, fX0, [&]() { p2_load_bfrag(fA1, fX1, GW, 1, h, wave, lane); fetch(itn); }, sp0, sh0, wave, lane);
        p2_dir<1>(k1, lds, hf, fA1, fX1, [&]() { p2_load_bfrag(fA0, fX0, GW, 0, itn & 7, wave, lane); }, sp1, sh1, wave, lane);
        pin0();
        if (has_next) put(itn, XRTn);
        if ((lane >> 4) == 0) { float* sm = SUMM + ((size_t)((b * NCHUNK + c) * 2) * 2) * DM + h * 128 + 16 * wave + (lane & 15); sm[0] = sp0; sm[DM] = sh0; sm[2 * DM] = sp1; sm[3 * DM] = sh1; }
        __syncthreads();
        { const int rr = tid >> 3, cc = tid & 7; const size_t grow = rowb + t0 + rr;
          const v4u wa_ = *(const LAS v4u*)(lds + P2_STA + rr * A8_PITCH + cc * 16), wb_ = *(const LAS v4u*)(lds + P2_STA + A8_TILE + rr * A8_PITCH + cc * 16);
          *(v4u*)(AF8 + grow * DM + h * 128 + cc * 16) = wa_; *(v4u*)(AB8 + grow * DM + h * 128 + cc * 16) = wb_; }
#pragma unroll
        for (int i = 0; i < 2; ++i) { const int e = tid + i * NTHREADS; const int rr = e >> 4, cc = e & 15; const size_t grow = rowb + t0 + rr;
            const v4u ws_ = *(const LAS v4u*)(lds + P2_STS + rr * ST_PITCH + cc * 16);
            *(v4u*)(MIX + grow * D_MIX + h * 128 + cc * 8) = ws_; }
    }
}
__device__ __forceinline__ void phase2b(const Args& a, int vcu, int G, int tid) {
    const float* SUMM = (const float*)(a.ws + WS_SUMM); float* CARRY = (float*)(a.ws + WS_CARRY);
    for (int i = vcu * NTHREADS + tid; i < BATCH * 2 * DM; i += G * NTHREADS) {
        const int ch = i & 1023, d = (i >> 10) & 1, b = i >> 11;
        float pa[NCHUNK], ph[NCHUNK];
#pragma unroll
        for (int k = 0; k < NCHUNK; ++k) { const float* sm = SUMM + ((size_t)((b * NCHUNK + k) * 2 + d) * 2) * DM + ch; pa[k] = sm[0]; ph[k] = sm[DM]; }
        float cv = 0.f;
        if (d == 0) {
#pragma unroll
            for (int k = 0; k < NCHUNK; ++k) { CARRY[(size_t)((b * NCHUNK + k) * 2 + d) * DM + ch] = cv; cv = pa[k] * cv + ph[k]; }
        } else {
#pragma unroll
            for (int k = NCHUNK - 1; k >= 0; --k) { CARRY[(size_t)((b * NCHUNK + k) * 2 + d) * DM + ch] = cv; cv = pa[k] * cv + ph[k]; }
        }
    }
}
struct P4Tok { v4u s[2], g[2], cbv, pc; v2u f[2], bk[2]; };
#define UB8(w, k) ((float)(((w) >> (8 * (k))) & 0xffu))
__device__ __forceinline__ float gelu_tanh_fast(float x) { const float u2 = 1.5957691216057308f * (x + 0.044715f * x * x * x); return x * __builtin_amdgcn_rcpf(1.0f + __builtin_amdgcn_exp2f(-1.4426950408889634f * u2)); }
__device__ __forceinline__ void p4_load(P4Tok& t, const bf16* MIX, const unsigned char* AFp, const unsigned char* ABp, const bf16* GATE, const bf16* CCX, size_t row, bool next_valid, int lane) {
#pragma unroll
    for (int hf = 0; hf < 2; ++hf) { const int ch = hf * 512 + 8 * lane;
        t.s[hf] = *(const v4u*)(MIX + row * D_MIX + ch); t.f[hf] = *(const v2u*)(AFp + row * DM + ch); t.bk[hf] = *(const v2u*)(ABp + row * DM + ch); t.g[hf] = *(const v4u*)(GATE + row * DM + ch); }
    t.cbv = *(const v4u*)(MIX + row * D_MIX + 1024 + 8 * lane);
    t.pc = next_valid ? *(const v4u*)(CCX + (row + 1) * 512 + 8 * lane) : (v4u){0u, 0u, 0u, 0u};
}
__device__ __forceinline__ void phase3(const Args& a, int vcu, int G, int wave, int lane, bool do_store) {
    unsigned char* ws = a.ws;
    bf16* MIX = (bf16*)(ws + WS_MIX); const unsigned char* AFp = (const unsigned char*)a.out; const unsigned char* ABp = AFp + (size_t)T * DM;
    const bf16* GATE = (const bf16*)(ws + WS_GATE); const bf16* CCX = (const bf16*)(ws + WS_CCX); const float* CARRY = (const float*)(ws + WS_CARRY);
    const float* cw = a.in[11]; const float* gnl = a.in[12]; const float* gnc = a.in[13];
    const __amdgpu_buffer_rsrc_t mixrs = __builtin_amdgcn_make_buffer_rsrc((void*)MIX, 0, (int)((size_t)T * D_MIX * 2), 0x00020000);
    float gn[16], w3[3][8], gc[8];
#pragma unroll
    for (int hf = 0; hf < 2; ++hf)
#pragma unroll
        for (int q = 0; q < 2; ++q) { const int ch = hf * 512 + 8 * lane + 4 * q; const f32x4 g = *(const f32x4*)(gnl + ch);
#pragma unroll
            for (int i = 0; i < 4; ++i) gn[hf * 8 + q * 4 + i] = g[i]; }
#pragma unroll
    for (int q = 0; q < 2; ++q) { const int ch = 8 * lane + 4 * q; const f32x4 g = *(const f32x4*)(gnc + ch);
#pragma unroll
        for (int k = 0; k < 3; ++k) { const f32x4 w = *(const f32x4*)(cw + k * 512 + ch);
#pragma unroll
            for (int i = 0; i < 4; ++i) w3[k][q * 4 + i] = w[i]; }
#pragma unroll
        for (int i = 0; i < 4; ++i) gc[q * 4 + i] = g[i]; }
    for (int item = vcu; item < BATCH * NCHUNK; item += G) {
        const int b = item >> 6, c = item & 63; const size_t row0 = (size_t)b * SEQ + c * LCH + 8 * wave; const int tpos0 = c * LCH + 8 * wave;
        float cf[16], cb[16];
#pragma unroll
        for (int hf = 0; hf < 2; ++hf)
#pragma unroll
            for (int q = 0; q < 2; ++q) { const int ch = hf * 512 + 8 * lane + 4 * q;
                const f32x4 f = *(const f32x4*)(CARRY + (size_t)((b * NCHUNK + c) * 2 + 0) * DM + ch), bk = *(const f32x4*)(CARRY + (size_t)((b * NCHUNK + c) * 2 + 1) * DM + ch);
#pragma unroll
                for (int i = 0; i < 4; ++i) { cf[hf * 8 + q * 4 + i] = f[i] * (1.f / 255.f); cb[hf * 8 + q * 4 + i] = bk[i] * (1.f / 255.f); } }
        float pm[8], p0[8], pp[8];
        { v4u c0 = (v4u){0u, 0u, 0u, 0u};
          if (tpos0 > 0) c0 = *(const v4u*)(CCX + (row0 - 1) * 512 + 8 * lane);
          const v4u c1 = *(const v4u*)(CCX + row0 * 512 + 8 * lane);
#pragma unroll
          for (int i = 0; i < 4; ++i) { pm[2 * i] = bflo(c0[i]); pm[2 * i + 1] = bfhi(c0[i]); p0[2 * i] = bflo(c1[i]); p0[2 * i + 1] = bfhi(c1[i]); } }
        P4Tok cur, nxt;
        p4_load(cur, MIX, AFp, ABp, GATE, CCX, row0, tpos0 + 1 < SEQ, lane);
#pragma unroll
        for (int i = 0; i < 8; ++i) {
            const size_t row = row0 + i;
            if (i + 1 < 8) p4_load(nxt, MIX, AFp, ABp, GATE, CCX, row + 1, tpos0 + i + 2 < SEQ, lane);
            float y[16]; float ss = 0.f;
#pragma unroll
            for (int hf = 0; hf < 2; ++hf)
#pragma unroll
                for (int e2 = 0; e2 < 4; ++e2) { const int e = hf * 8 + 2 * e2;
                    const unsigned fw = cur.f[hf][e2 >> 1], bw = cur.bk[hf][e2 >> 1];
                    const float l0 = bflo(cur.s[hf][e2]) + UB8(fw, (2 * e2) & 3) * cf[e] + UB8(bw, (2 * e2) & 3) * cb[e], l1 = bfhi(cur.s[hf][e2]) + UB8(fw, (2 * e2 + 1) & 3) * cf[e + 1] + UB8(bw, (2 * e2 + 1) & 3) * cb[e + 1];
                    y[e] = gelu_tanh_fast(bflo(cur.g[hf][e2])) * l0; y[e + 1] = gelu_tanh_fast(bfhi(cur.g[hf][e2])) * l1; ss += y[e] * y[e] + y[e + 1] * y[e + 1]; }
#pragma unroll
            for (int e2 = 0; e2 < 4; ++e2) { pp[2 * e2] = bflo(cur.pc[e2]); pp[2 * e2 + 1] = bfhi(cur.pc[e2]); }
            float yc[8]; float ssc = 0.f;
#pragma unroll
            for (int e2 = 0; e2 < 4; ++e2) { const float a0 = w3[0][2 * e2] * pm[2 * e2] + w3[1][2 * e2] * p0[2 * e2] + w3[2][2 * e2] * pp[2 * e2], a1 = w3[0][2 * e2 + 1] * pm[2 * e2 + 1] + w3[1][2 * e2 + 1] * p0[2 * e2 + 1] + w3[2][2 * e2 + 1] * pp[2 * e2 + 1];
                yc[2 * e2] = a0 * bflo(cur.cbv[e2]); yc[2 * e2 + 1] = a1 * bfhi(cur.cbv[e2]); ssc += yc[2 * e2] * yc[2 * e2] + yc[2 * e2 + 1] * yc[2 * e2 + 1]; }
#pragma unroll
            for (int o = 1; o < 64; o <<= 1) { ss += __shfl_xor(ss, o); ssc += __shfl_xor(ssc, o); }
            const float r = __builtin_amdgcn_rsqf(ss * (1.f / 1024.f) + RMS_EPS), r2 = __builtin_amdgcn_rsqf(ssc * (1.f / 512.f) + RMS_EPS);
#pragma unroll
            for (int hf = 0; hf < 2; ++hf) { v4u o;
#pragma unroll
                for (int e2 = 0; e2 < 4; ++e2) { const int e = hf * 8 + 2 * e2; o[e2] = pk2(y[e] * r * gn[e], y[e + 1] * r * gn[e + 1]); }
                if (do_store) ST16_WTB(mixrs, (int)((row * D_MIX + hf * 512 + 8 * lane) * 2), o); else asm volatile("" :: "v"(o)); }
            { v4u oc;
#pragma unroll
              for (int e2 = 0; e2 < 4; ++e2) oc[e2] = pk2(yc[2 * e2] * r2 * gc[2 * e2], yc[2 * e2 + 1] * r2 * gc[2 * e2 + 1]);
              if (do_store) ST16_WTB(mixrs, (int)((row * D_MIX + 1024 + 8 * lane) * 2), oc); else asm volatile("" :: "v"(oc)); }
#pragma unroll
            for (int e = 0; e < 8; ++e) { pm[e] = p0[e]; p0[e] = pp[e]; }
            if (i + 1 < 8) cur = nxt;
        }
    }
}
__device__ __forceinline__ void phase5(const Args& a, int vcu, int G, int tid, int wave, int lane) {
    unsigned char* ws = a.ws;
    const int gw = vcu * NWAVES + wave, NGW = G * NWAVES;
    ln_rows_bf16((const bf16*)(ws + WS_PRE1), a.in[15], a.in[16], (bf16*)(ws + WS_H1), gw, NGW, lane);
#if !TABLE_FP4
    const size_t NV = (size_t)16384 * 1024 / 16;
    for (size_t i = (size_t)vcu * NTHREADS + tid; i < 2 * NV; i += (size_t)G * NTHREADS) {
        const bool second = i >= NV; const size_t j = second ? i - NV : i;
        const float* src = (second ? a.in[21] : a.in[20]) + j * 16;
        const float sc = second ? V_SCALE : U_SCALE;
        unsigned char* dst = ws + (second ? WS_V8 : WS_U8) + j * 16;
        v4u o;
#pragma unroll
        for (int q = 0; q < 4; ++q) { f32x4 v = *(const f32x4*)(src + 4 * q) * sc;
#pragma unroll
            for (int e = 0; e < 4; ++e) v[e] = fminf(fmaxf(v[e], -224.f), 224.f);
            int w = 0; w = __builtin_amdgcn_cvt_pk_fp8_f32(v[0], v[1], w, false); w = __builtin_amdgcn_cvt_pk_fp8_f32(v[2], v[3], w, true); o[q] = (unsigned)w; }
        *(v4u*)dst = o;
    }
#endif
}
#define INS16(v, x) do { _Pragma("unroll") for (int j_ = 15; j_ >= 1; --j_) v[j_] = __builtin_amdgcn_fmed3f(v[j_ - 1], v[j_], (x)); v[0] = fmaxf(v[0], (x)); } while (0)
typedef float f32x16 __attribute__((ext_vector_type(16)));
constexpr int KP = 272;
#define CE_(v, a, b) do { const float hi_ = fmaxf(v[a], v[b]), lo_ = fminf(v[a], v[b]); v[a] = hi_; v[b] = lo_; } while (0)
__device__ __forceinline__ void sort16_desc(float (&t)[16]) {
    CE_(t,0,13); CE_(t,1,12); CE_(t,2,15); CE_(t,3,14); CE_(t,4,8); CE_(t,5,6); CE_(t,7,11); CE_(t,9,10);
    CE_(t,0,5); CE_(t,1,7); CE_(t,2,9); CE_(t,3,4); CE_(t,6,13); CE_(t,8,14); CE_(t,10,15); CE_(t,11,12);
    CE_(t,0,1); CE_(t,2,3); CE_(t,4,5); CE_(t,6,8); CE_(t,7,9); CE_(t,10,11); CE_(t,12,13); CE_(t,14,15);
    CE_(t,0,2); CE_(t,1,3); CE_(t,4,10); CE_(t,5,11); CE_(t,6,7); CE_(t,8,9); CE_(t,12,14); CE_(t,13,15);
    CE_(t,1,2); CE_(t,3,12); CE_(t,4,6); CE_(t,5,7); CE_(t,8,10); CE_(t,9,11); CE_(t,13,14);
    CE_(t,1,4); CE_(t,2,6); CE_(t,5,8); CE_(t,7,10); CE_(t,9,13); CE_(t,11,14);
    CE_(t,2,4); CE_(t,3,6); CE_(t,9,12); CE_(t,11,13);
    CE_(t,3,5); CE_(t,6,8); CE_(t,7,9); CE_(t,10,12);
    CE_(t,3,4); CE_(t,5,6); CE_(t,7,8); CE_(t,9,10); CE_(t,11,12);
    CE_(t,6,7); CE_(t,8,9);
}
__device__ __forceinline__ void merge16_desc(float (&v)[16], const float (&t)[16]) {
#pragma unroll
    for (int j = 0; j < 16; ++j) v[j] = fmaxf(v[j], t[15 - j]);
#pragma unroll
    for (int d = 8; d >= 1; d >>= 1)
#pragma unroll
        for (int i = 0; i < 16; ++i) if ((i & d) == 0) CE_(v, i, i + d);
}
__device__ __forceinline__ void topk_list(const LAS unsigned char* Kl, const bf16* Qrow, int lane, float (&v)[16]) {
    const int r = lane & 31, hh = lane >> 5;
    bf16x8 qf[8];
#pragma unroll
    for (int ks = 0; ks < 8; ++ks) qf[ks] = *(const bf16x8*)(Qrow + ks * 16 + 8 * hh);
#pragma unroll
    for (int j = 0; j < 16; ++j) v[j] = -3.0e38f;
#pragma unroll 1
    for (int m = 0; m < 4; ++m) {
        f32x16 acc;
#pragma unroll
        for (int i = 0; i < 16; ++i) acc[i] = 0.f;
#pragma unroll
        for (int ks = 0; ks < 8; ++ks) { const bf16x8 kf = *(const LAS bf16x8*)(Kl + (32 * m + r) * KP + (ks * 16 + 8 * hh) * 2);
            acc = __builtin_amdgcn_mfma_f32_32x32x16_bf16(kf, qf[ks], acc, 0, 0, 0); }
        float t16[16];
#pragma unroll
        for (int i = 0; i < 16; ++i) { const unsigned kid = (unsigned)(32 * m + (i & 3) + 8 * (i >> 2) + 4 * hh);
            const float sc_ = acc[i]; t16[i] = __uint_as_float((__float_as_uint(sc_) & ~0x7Fu) | kid); }
        sort16_desc(t16); merge16_desc(v, t16);
    }
    float o[16];
#pragma unroll
    for (int j = 0; j < 16; ++j) o[j] = __shfl_xor(v[j], 32);
    merge16_desc(v, o);
}
__device__ __forceinline__ void phase7(const Args& a, LAS unsigned char* lds, int vcu, int G, int tid, int wave, int lane) {
    unsigned char* ws = a.ws;
    const bf16* Q = (const bf16*)(ws + WS_Q);
    int* IDX = (int*)(ws + WS_IDX); float* Gp = (float*)(ws + WS_G);
    for (int q = tid; q < 2 * 128 * 16; q += NTHREADS) { const int which = q >> 11, row = (q >> 4) & 127, ch = q & 15;
        const v4u kv = *(const v4u*)((const bf16*)(ws + (which ? WS_K2 : WS_K1)) + row * 128 + ch * 8);
        *(LAS v4u*)(lds + which * 128 * KP + row * KP + ch * 16) = kv; }
    __syncthreads();
    const int gw = vcu * NWAVES + wave, NGW = G * NWAVES;
    for (int item = gw; item < (T / 32) * 8; item += NGW) {
        const int h = item & 7, tg = item >> 3; const size_t row = (size_t)tg * 32 + (lane & 31);
        const bf16* Qrow = Q + row * D_Q + h * 256;
#if TABLE_FP4
        TabGroup tgr[4]; const size_t tg0 = (size_t)item * 256 + lane;
#pragma unroll
        for (int gi = 0; gi < 4; ++gi) if (tg0 + 64 * gi < 2 * TAB_GROUPS) tab_load(tgr[gi], a, tg0 + 64 * gi);
#endif
        float va[16], vb[16];
        topk_list(lds, Qrow, lane, va);
        topk_list(lds + 128 * KP, Qrow + 128, lane, vb);
        float cnd[16]; float sa[16], sb[16];
#pragma unroll
        for (int j = 0; j < 16; ++j) { sa[j] = __builtin_bit_cast(float, __builtin_bit_cast(unsigned, va[j]) & ~0x7Fu); sb[j] = __builtin_bit_cast(float, __builtin_bit_cast(unsigned, vb[j]) & ~0x7Fu); cnd[j] = -3.0e38f; }
        { float kc[50]; int cnt = 0;
#pragma unroll
          for (int i = 0; i < 16; ++i)
#pragma unroll
              for (int j = 0; j < 16; ++j) if ((i + 1) * (j + 1) <= 16) { kc[cnt] = __builtin_bit_cast(float, (__builtin_bit_cast(unsigned, sa[i] + sb[j]) & ~0xFFu) | (unsigned)(i * 16 + j)); ++cnt; }
          const bool odd = (lane >> 5) != 0;
#pragma unroll
          for (int p = 0; p < 25; ++p) { const float key = odd ? kc[2 * p + 1] : kc[2 * p]; INS16(cnd, key); }
          float oc[16];
#pragma unroll
          for (int j = 0; j < 16; ++j) oc[j] = __shfl_xor(cnd[j], 32);
          merge16_desc(cnd, oc); }
        LAS unsigned char* tb = lds + 2 * 128 * KP + wave * 2048 + lane * 32;
#pragma unroll
        for (int j = 0; j < 16; ++j) { tb[j] = (unsigned char)__builtin_bit_cast(unsigned, va[j]); tb[16 + j] = (unsigned char)__builtin_bit_cast(unsigned, vb[j]); }
        const float mx = __builtin_bit_cast(float, __builtin_bit_cast(unsigned, cnd[0]) & ~0xFFu);
        const int hh8 = lane >> 5;
        float e[8]; float sum = 0.f; unsigned ids[8];
#pragma unroll
        for (int k = 0; k < 8; ++k) { float hv_ = cnd[8 + k]; asm volatile("" : "+v"(hv_));
            const unsigned bits = __builtin_bit_cast(unsigned, hh8 ? hv_ : cnd[k]); const unsigned pi = (bits >> 4) & 15u, pj = bits & 15u;
            e[k] = __expf(__builtin_bit_cast(float, bits & ~0xFFu) - mx); sum += e[k];
            const unsigned i1 = (unsigned)tb[pi] & 0x7Fu, i2 = (unsigned)tb[16 + pj] & 0x7Fu;
            ids[k] = i1 * 128u + i2; }
        sum += __shfl_xor(sum, 32);
        const float inv = 1.0f / sum; const size_t o = row * 128 + h * 16 + 8 * hh8;
#pragma unroll
        for (int k = 0; k < 8; k += 4) { *(v4u*)(IDX + o + k) = (v4u){ids[k], ids[k + 1], ids[k + 2], ids[k + 3]};
            *(f32x4*)(Gp + o + k) = (f32x4){e[k] * inv, e[k + 1] * inv, e[k + 2] * inv, e[k + 3] * inv}; }
#if TABLE_FP4
#pragma unroll
        for (int gi = 0; gi < 4; ++gi) if (tg0 + 64 * gi < 2 * TAB_GROUPS) tab_store(tgr[gi], a, tg0 + 64 * gi);
#endif
    }
#if TABLE_FP4
    for (size_t i2 = (size_t)(T / 32) * 8 * 256 + (size_t)gw * 64 + lane; i2 < 2 * TAB_GROUPS; i2 += (size_t)NGW * 64) { TabGroup tg1; tab_load(tg1, a, i2); tab_store(tg1, a, i2); }
#endif
    __syncthreads();
}
#if TABLE_FP4
typedef float f32x2 __attribute__((ext_vector_type(2)));
typedef _Float16 h16x2 __attribute__((ext_vector_type(2)));
typedef unsigned v2u_ __attribute__((ext_vector_type(2)));
#define P8_LOADB(buf, RSRC, b0) do { _Pragma("unroll") for (int k_ = 0; k_ < 16; ++k_) { const int ie_ = __builtin_amdgcn_readlane(idr, (b0) + k_); \
    buf[k_] = __builtin_bit_cast(v2u, __builtin_amdgcn_raw_buffer_load_b64((RSRC), voff, ie_ * ROWB, 0)); } } while (0)
__device__ __forceinline__ void phase8a(const Args& a, int vcu, int G, int wave, int lane) {
    unsigned char* ws = a.ws;
    const bf16* H1 = (const bf16*)(ws + WS_H1); const unsigned char* U8 = ws + WS_U8;
    const int* IDX = (const int*)(ws + WS_IDX); float* DOT = (float*)(ws + WS_DOT);
    const __amdgpu_buffer_rsrc_t urs = __builtin_amdgcn_make_buffer_rsrc((void*)U8, 0, 16384 * ROWB, 0x00020000); const int voff = 8 * lane;
    const int gw = vcu * NWAVES + wave, NGW = G * NWAVES;
    for (int t = gw; t < T; t += NGW) {
        const v4u xa = *(const v4u*)(H1 + (size_t)t * DM + 16 * lane), xb = *(const v4u*)(H1 + (size_t)t * DM + 16 * lane + 8);
        float xf[16];
#pragma unroll
        for (int i = 0; i < 4; ++i) { xf[2 * i] = bflo(xa[i]); xf[2 * i + 1] = bfhi(xa[i]); xf[8 + 2 * i] = bflo(xb[i]); xf[8 + 2 * i + 1] = bfhi(xb[i]); }
        float amax = 1e-20f;
#pragma unroll
        for (int i = 0; i < 16; ++i) amax = fmaxf(amax, fabsf(xf[i]));
#pragma unroll
        for (int o = 1; o < 64; o <<= 1) amax = fmaxf(amax, __shfl_xor(amax, o));
        const float sx = 119.0f / amax;
        unsigned xh[2] = {0u, 0u}, xl[2] = {0u, 0u}; int sxi = 0;
#pragma unroll
        for (int i = 0; i < 16; ++i) { const int xi = (int)rintf(xf[i] * sx); const int lo = ((xi + 8) & 15) - 8, hi = (xi - lo) >> 4; sxi += xi;
            xh[i >> 3] |= ((unsigned)hi & 15u) << (4 * (i & 7)); xl[i >> 3] |= ((unsigned)lo & 15u) << (4 * (i & 7)); }
#pragma unroll
        for (int o = 1; o < 64; o <<= 1) sxi += __shfl_xor(sxi, o);
        const float dscale = U_STEP / sx;
#pragma unroll 1
        for (int part = 0; part < 2; ++part) {
            const int idr = IDX[(size_t)t * 128 + part * 64 + lane];
            int p[64]; v2u ub[2][16];
            P8_LOADB(ub[0], urs, 0);
#pragma unroll
            for (int bb = 0; bb < 4; ++bb) {
                if (bb + 1 < 4) P8_LOADB(ub[(bb + 1) & 1], urs, 16 * (bb + 1));
                __builtin_amdgcn_sched_barrier(0);
#pragma unroll
                for (int k = 0; k < 16; ++k) { const v2u uw = ub[bb & 1][k];
                    int ah = __builtin_amdgcn_sdot8((int)uw[0], (int)xh[0], 0, false); ah = __builtin_amdgcn_sdot8((int)uw[1], (int)xh[1], ah, false);
                    int al = __builtin_amdgcn_sdot8((int)uw[0], (int)xl[0], 0, false); al = __builtin_amdgcn_sdot8((int)uw[1], (int)xl[1], al, false);
                    p[16 * bb + k] = 16 * ah + al; }
                __builtin_amdgcn_sched_barrier(0);
            }
#pragma unroll
            for (int i = 0; i < 32; ++i) { const auto r_ = __builtin_amdgcn_permlane32_swap((unsigned)p[i], (unsigned)p[i + 32], false, false); p[i] = (int)r_[0] + (int)r_[1]; }
#pragma unroll
            for (int i = 0; i < 16; ++i) { const auto r_ = __builtin_amdgcn_permlane16_swap((unsigned)p[i], (unsigned)p[i + 16], false, false); p[i] = (int)r_[0] + (int)r_[1]; }
#pragma unroll
            for (int sft = 8; sft >= 1; sft >>= 1) { const bool up = (lane & sft) != 0;
#pragma unroll
                for (int i = 0; i < sft; ++i) { const int send = up ? p[i] : p[i + sft], keep = up ? p[i + sft] : p[i]; p[i] = keep + __shfl_xor(send, sft); } }
            DOT[(size_t)t * 128 + part * 64 + lane] = dscale * ((float)p[0] + 0.5f * (float)sxi);
        }
    }
}
__device__ __forceinline__ void phase8b(const Args& a, int vcu, int G, int wave, int lane) {
    unsigned char* ws = a.ws;
    const bf16* H1 = (const bf16*)(ws + WS_H1); const unsigned char* V8 = ws + WS_V8;
    const int* IDX = (const int*)(ws + WS_IDX); const float* Gp = (const float*)(ws + WS_G); const float* DOT = (const float*)(ws + WS_DOT);
    const float* g2 = a.in[22]; const float* b2 = a.in[23];
    const __amdgpu_buffer_rsrc_t vrs = __builtin_amdgcn_make_buffer_rsrc((void*)V8, 0, 16384 * ROWB, 0x00020000); const int voff = 8 * lane;
    const int gw = vcu * NWAVES + wave, NGW = G * NWAVES;
    for (int t = gw; t < T; t += NGW) {
        h16x2 y16[8];
#pragma unroll
        for (int i = 0; i < 8; ++i) y16[i] = (h16x2){(_Float16)0.f, (_Float16)0.f};
#pragma unroll 1
        for (int part = 0; part < 2; ++part) {
            const int idr = IDX[(size_t)t * 128 + part * 64 + lane]; const float gr = Gp[(size_t)t * 128 + part * 64 + lane], dot = DOT[(size_t)t * 128 + part * 64 + lane];
            v2u vb[2][16];
            P8_LOADB(vb[0], vrs, 0);
            const float wv = gr * gelu_erf(dot) * (1.0f / V_SCALE);
            const h16x2 wh = (h16x2){(_Float16)wv, (_Float16)wv}; const int wbits = __builtin_bit_cast(int, wh);
#pragma unroll
            for (int bb = 0; bb < 4; ++bb) {
                if (bb + 1 < 4) P8_LOADB(vb[(bb + 1) & 1], vrs, 16 * (bb + 1));
                __builtin_amdgcn_sched_barrier(0);
#pragma unroll
                for (int k = 0; k < 16; ++k) { const h16x2 we = __builtin_bit_cast(h16x2, __builtin_amdgcn_readlane(wbits, 16 * bb + k)); const v2u vw = vb[bb & 1][k];
#pragma unroll
                    for (int q = 0; q < 2; ++q) { const unsigned wq = vw[q];
                        y16[4 * q] = __builtin_elementwise_fma(__builtin_bit_cast(h16x2, __builtin_amdgcn_cvt_scalef32_pk_f16_fp4(wq, 1.0f, 0)), we, y16[4 * q]);
                        y16[4 * q + 1] = __builtin_elementwise_fma(__builtin_bit_cast(h16x2, __builtin_amdgcn_cvt_scalef32_pk_f16_fp4(wq, 1.0f, 1)), we, y16[4 * q + 1]);
                        y16[4 * q + 2] = __builtin_elementwise_fma(__builtin_bit_cast(h16x2, __builtin_amdgcn_cvt_scalef32_pk_f16_fp4(wq, 1.0f, 2)), we, y16[4 * q + 2]);
                        y16[4 * q + 3] = __builtin_elementwise_fma(__builtin_bit_cast(h16x2, __builtin_amdgcn_cvt_scalef32_pk_f16_fp4(wq, 1.0f, 3)), we, y16[4 * q + 3]); } }
                __builtin_amdgcn_sched_barrier(0);
            }
        }
        const v4u xa = *(const v4u*)(H1 + (size_t)t * DM + 16 * lane), xb = *(const v4u*)(H1 + (size_t)t * DM + 16 * lane + 8);
        float y[16]; float s = 0.f;
#pragma unroll
        for (int i = 0; i < 4; ++i) { y[2 * i] = (float)y16[i].x + ALPHA * bflo(xa[i]); y[2 * i + 1] = (float)y16[i].y + ALPHA * bfhi(xa[i]); y[8 + 2 * i] = (float)y16[4 + i].x + ALPHA * bflo(xb[i]); y[8 + 2 * i + 1] = (float)y16[4 + i].y + ALPHA * bfhi(xb[i]); }
#pragma unroll
        for (int i = 0; i < 16; ++i) s += y[i];
        const float mean = wave_sum(s) * (1.f / DM); float s2 = 0.f;
#pragma unroll
        for (int i = 0; i < 16; ++i) { y[i] -= mean; s2 += y[i] * y[i]; }
        const float rstd = __builtin_amdgcn_rsqf(wave_sum(s2) * (1.f / DM) + LN_EPS);
#pragma unroll
        for (int q = 0; q < 4; ++q) { const int col = 16 * lane + 4 * q; const f32x4 gv = *(const f32x4*)(g2 + col), bv = *(const f32x4*)(b2 + col);
            f32x4 o; o[0] = y[4 * q] * rstd * gv[0] + bv[0]; o[1] = y[4 * q + 1] * rstd * gv[1] + bv[1]; o[2] = y[4 * q + 2] * rstd * gv[2] + bv[2]; o[3] = y[4 * q + 3] * rstd * gv[3] + bv[3];
            *(f32x4*)(a.out + (size_t)t * DM + col) = o; }
    }
}
#undef P8_LOADB
#else
typedef float f32x2 __attribute__((ext_vector_type(2)));
__device__ __forceinline__ void phase8(const Args& a, int vcu, int G, int wave, int lane) {
    unsigned char* ws = a.ws;
    const bf16* H1 = (const bf16*)(ws + WS_H1); const unsigned char* U8 = ws + WS_U8; const unsigned char* V8 = ws + WS_V8;
    const int* IDX = (const int*)(ws + WS_IDX); const float* Gp = (const float*)(ws + WS_G);
    const float* g2 = a.in[22]; const float* b2 = a.in[23];
    const int gw = vcu * NWAVES + wave, NGW = G * NWAVES;
    for (int t = gw; t < T; t += NGW) {
        const v4u xa = *(const v4u*)(H1 + (size_t)t * DM + 16 * lane), xb = *(const v4u*)(H1 + (size_t)t * DM + 16 * lane + 8);
        f32x2 x2[8], y2[8];
#pragma unroll
        for (int i = 0; i < 4; ++i) { x2[i] = (f32x2){bflo(xa[i]), bfhi(xa[i])}; x2[4 + i] = (f32x2){bflo(xb[i]), bfhi(xb[i])}; }
#pragma unroll
        for (int i = 0; i < 8; ++i) y2[i] = (f32x2){0.f, 0.f};
#pragma unroll 1
        for (int part = 0; part < 2; ++part) {
            const int idr = IDX[(size_t)t * 128 + part * 64 + lane]; const float gr = Gp[(size_t)t * 128 + part * 64 + lane];
            float p[64];
#pragma unroll
            for (int e = 0; e < 64; ++e) {
                const int ie = __builtin_amdgcn_readlane(idr, e);
                f32x2 acc = (f32x2){0.f, 0.f};
#if TABLE_FP4
                const v2u uw = *(const v2u*)(U8 + (size_t)ie * ROWB + 8 * lane);
#pragma unroll
                for (int q = 0; q < 2; ++q) { const unsigned wq = uw[q];
                    acc += __builtin_amdgcn_cvt_scalef32_pk_f32_fp4(wq, 1.0f, 0) * x2[4 * q]; acc += __builtin_amdgcn_cvt_scalef32_pk_f32_fp4(wq, 1.0f, 1) * x2[4 * q + 1];
                    acc += __builtin_amdgcn_cvt_scalef32_pk_f32_fp4(wq, 1.0f, 2) * x2[4 * q + 2]; acc += __builtin_amdgcn_cvt_scalef32_pk_f32_fp4(wq, 1.0f, 3) * x2[4 * q + 3]; }
#else
                const v4u uw = *(const v4u*)(U8 + (size_t)ie * ROWB + 16 * lane);
#pragma unroll
                for (int q = 0; q < 4; ++q) { const f32x2 lo = __builtin_amdgcn_cvt_pk_f32_fp8((int)uw[q], false), hi = __builtin_amdgcn_cvt_pk_f32_fp8((int)uw[q], true);
                    acc += lo * x2[2 * q]; acc += hi * x2[2 * q + 1]; }
#endif
                p[e] = acc.x + acc.y;
            }
#pragma unroll
            for (int sft = 32; sft >= 1; sft >>= 1) { const bool up = (lane & sft) != 0;
#pragma unroll
                for (int i = 0; i < sft; ++i) { const float send = up ? p[i] : p[i + sft], keep = up ? p[i + sft] : p[i]; p[i] = keep + __shfl_xor(send, sft); } }
            const float wv = gr * gelu_erf(p[0] * (1.0f / U_SCALE)) * (1.0f / V_SCALE);
#pragma unroll
            for (int e = 0; e < 64; ++e) {
                const int ie = __builtin_amdgcn_readlane(idr, e); const float we = __builtin_bit_cast(float, __builtin_amdgcn_readlane(__builtin_bit_cast(int, wv), e));
#if TABLE_FP4
                const v2u vw = *(const v2u*)(V8 + (size_t)ie * ROWB + 8 * lane);
#pragma unroll
                for (int q = 0; q < 2; ++q) { const unsigned wq = vw[q];
                    y2[4 * q] += __builtin_amdgcn_cvt_scalef32_pk_f32_fp4(wq, 1.0f, 0) * we; y2[4 * q + 1] += __builtin_amdgcn_cvt_scalef32_pk_f32_fp4(wq, 1.0f, 1) * we;
                    y2[4 * q + 2] += __builtin_amdgcn_cvt_scalef32_pk_f32_fp4(wq, 1.0f, 2) * we; y2[4 * q + 3] += __builtin_amdgcn_cvt_scalef32_pk_f32_fp4(wq, 1.0f, 3) * we; }
#else
                const v4u vw = *(const v4u*)(V8 + (size_t)ie * ROWB + 16 * lane);
#pragma unroll
                for (int q = 0; q < 4; ++q) { const f32x2 lo = __builtin_amdgcn_cvt_pk_f32_fp8((int)vw[q], false), hi = __builtin_amdgcn_cvt_pk_f32_fp8((int)vw[q], true);
                    y2[2 * q] += lo * we; y2[2 * q + 1] += hi * we; }
#endif
            }
        }
        float s = 0.f;
#pragma unroll
        for (int i = 0; i < 8; ++i) { y2[i] += x2[i] * ALPHA; s += y2[i].x + y2[i].y; }
        const float mean = wave_sum(s) * (1.f / DM); float s2 = 0.f;
#pragma unroll
        for (int i = 0; i < 8; ++i) { y2[i] -= mean; s2 += y2[i].x * y2[i].x + y2[i].y * y2[i].y; }
        const float rstd = 1.0f / sqrtf(wave_sum(s2) * (1.f / DM) + LN_EPS);
#pragma unroll
        for (int q = 0; q < 4; ++q) { const int col = 16 * lane + 4 * q; const f32x4 gv = *(const f32x4*)(g2 + col), bv = *(const f32x4*)(b2 + col);
            f32x4 o; o[0] = y2[2 * q].x * rstd * gv[0] + bv[0]; o[1] = y2[2 * q].y * rstd * gv[1] + bv[1]; o[2] = y2[2 * q + 1].x * rstd * gv[2] + bv[2]; o[3] = y2[2 * q + 1].y * rstd * gv[3] + bv[3];
            *(f32x4*)(a.out + (size_t)t * DM + col) = o; }
    }
}

#endif

constexpr int NPHASES = 10 + TABLE_FP4;
__global__ void __launch_bounds__(NTHREADS, 2) hymba_fwd(Args args) {
    extern __shared__ __attribute__((aligned(16))) unsigned char lds_raw[];
    LAS unsigned char* lds = (LAS unsigned char*)lds_raw;
    const int tid = threadIdx.x, lane = tid & 63, wave = __builtin_amdgcn_readfirstlane(tid >> 6);
    const int G = gridDim.x; const int bx = blockIdx.x; const int vcu = (G % 8 == 0) ? (bx % 8) * (G / 8) + bx / 8 : bx;
    unsigned char* ws = args.ws;
    const int lo = args.ph_lo, hi = args.ph_hi;
#if ONE_LAUNCH
    volatile LAS unsigned* misc = (volatile LAS unsigned*)(lds + MISC_OFF);
    if (tid < 16) misc[tid] = 0u;
    __syncthreads();
    const XcdBarrier xbar = xcd_barrier_post((unsigned*)(ws + WS_CTL) + 4096, misc);
#define XCD_SYNC() xcd_barrier(xbar)
#else
#define XCD_SYNC() do {} while (0)
#endif
#define IN(k) (lo <= (k) && (k) < hi)
#ifdef REP
#define REPS(k) ((k) == REP ? 2 : 1)
#else
#define REPS(k) 1
#endif
#ifdef ONLY
#define PH_ON(k) ((k) == ONLY)
#else
#define PH_ON(k) true
#endif
#define SEAM(k) do { if (IN(k) && IN((k) + 1)) { XCD_SYNC(); } } while (0)
    if (hi > 1000) { GRID_SYNC(); }
    if (PH_ON(0) && IN(0)) for (int rep_ = 0; rep_ < REPS(0); ++rep_) { phase0(args, lds, vcu, G, wave, lane); } SEAM(0);
    if (PH_ON(1) && IN(1)) for (int rep_ = 0; rep_ < REPS(1); ++rep_) { pg8::Gemm g{(const bf16*)(ws + WS_H0), (const bf16*)(ws + WS_WIN), T, D_IN, DM}; pg8::StaticOrder S; S.init(T, D_IN, G, bx);
        EpiIn E{(bf16*)(ws + WS_XR), (bf16*)(ws + WS_GATE), (bf16*)(ws + WS_MIX), (bf16*)(ws + WS_CCX)};
        pg8::gemm_phase<EpiIn, pg8::StaticOrder, true, true>(lds, g, S, E); } SEAM(1);
    if (PH_ON(2) && IN(2)) { for (int rep = 0; rep < REPS(2); ++rep) phase2(args, lds, vcu, G, tid, wave, lane); } SEAM(2);
    if (PH_ON(3) && IN(3)) for (int rep_ = 0; rep_ < REPS(3); ++rep_) { phase2b(args, vcu, G, tid); } SEAM(3);
    if (PH_ON(4) && IN(4)) for (int rep_ = 0; rep_ < REPS(4); ++rep_) { phase3(args, vcu, G, wave, lane, rep_ == REPS(4) - 1); } SEAM(4);
    if (PH_ON(5) && IN(5)) for (int rep_ = 0; rep_ < REPS(5); ++rep_) { pg8::Gemm g{(const bf16*)(ws + WS_MIX), (const bf16*)(ws + WS_WOUT), T, DM, D_MIX}; pg8::StaticOrder S; S.init(T, DM, G, bx);
        EpiPre E{(const bf16*)(ws + WS_H0), (bf16*)(ws + WS_PRE1)};
        pg8::gemm_phase<EpiPre, pg8::StaticOrder, true, true>(lds, g, S, E); } SEAM(5);
    if (PH_ON(6) && IN(6)) for (int rep_ = 0; rep_ < REPS(6); ++rep_) { phase5(args, vcu, G, tid, wave, lane); } SEAM(6);
    if (PH_ON(7) && IN(7)) for (int rep_ = 0; rep_ < REPS(7); ++rep_) { pg8::Gemm g{(const bf16*)(ws + WS_H1), (const bf16*)(ws + WS_WQ), T, D_Q, DM}; pg8::StaticOrder S; S.init(T, D_Q, G, bx);
        pg8::EpiBf16<0> E{(bf16*)(ws + WS_Q), D_Q, nullptr, 0, 0, 1.f};
        pg8::gemm_phase<pg8::EpiBf16<0>, pg8::StaticOrder, true, true>(lds, g, S, E); } SEAM(7);
    if (PH_ON(8) && IN(8)) { for (int rep = 0; rep < REPS(8); ++rep) phase7(args, lds, vcu, G, tid, wave, lane); } SEAM(8);
#if TABLE_FP4
    if (PH_ON(9) && IN(9)) { for (int rep = 0; rep < REPS(9); ++rep) phase8a(args, vcu, G, wave, lane); }
    if (PH_ON(10) && IN(10)) { for (int rep = 0; rep < REPS(10); ++rep) phase8b(args, vcu, G, wave, lane); }
#else
    if (PH_ON(9) && IN(9)) { for (int rep = 0; rep < REPS(9); ++rep) phase8(args, vcu, G, wave, lane); }
#endif
#undef IN
#undef SEAM
}

extern "C" void kernel_launch(void* const* d_in, const int* in_sizes, int n_in, void* d_out, int out_size, void* d_ws, size_t ws_size, hipStream_t stream) {
    static int grid = 0;
    if (grid == 0) {
        if (n_in != 24 || out_size != T * DM || ws_size < WS_END) { fprintf(stderr, "kernel_launch: unexpected shapes n_in %d out %d ws %zu\n", n_in, out_size, ws_size); grid = -1; return; }
        int dev = 0, cus = 0, per_cu = 0;
        (void)hipGetDevice(&dev); (void)hipDeviceGetAttribute(&cus, hipDeviceAttributeMultiprocessorCount, dev);
        if (hipFuncSetAttribute((const void*)hymba_fwd, hipFuncAttributeMaxDynamicSharedMemorySize, LDS_BYTES) != hipSuccess) { fprintf(stderr, "hipFuncSetAttribute failed\n"); grid = -1; return; }
        (void)hipOccupancyMaxActiveBlocksPerMultiprocessor(&per_cu, (const void*)hymba_fwd, NTHREADS, LDS_BYTES);
        (void)hipGetLastError();
        if (per_cu < 1) { fprintf(stderr, "occupancy query says %d blocks per CU\n", per_cu); grid = -1; return; }
        grid = cus;
    }
    if (grid < 0) return;
    Args a{};
    for (int i = 0; i < 24; ++i) a.in[i] = (const float*)d_in[i];
    a.out = (float*)d_out; a.ws = (unsigned char*)d_ws;
#if ONE_LAUNCH
    (void)hipMemsetAsync((char*)d_ws + WS_CTL, 0, CTL_ZERO_BYTES, stream);
    a.ph_lo = 0; a.ph_hi = NPHASES;
    void* kargs[] = {&a};
    hipError_t e = hipLaunchCooperativeKernel((const void*)hymba_fwd, dim3(grid), dim3(NTHREADS), kargs, LDS_BYTES, stream);
    if (e != hipSuccess) fprintf(stderr, "cooperative launch failed: %s (grid %d)\n", hipGetErrorString(e), grid);
#else
    for (int p = 0; p < NPHASES; ++p) { a.ph_lo = p; a.ph_hi = p + 1; hipLaunchKernelGGL(hymba_fwd, dim3(grid), dim3(NTHREADS), LDS_BYTES, stream, a); }
#endif
}
```

```cpp
#include <hip/hip_runtime.h>
#include <hip/hip_cooperative_groups.h>
#include <cstdio>
#include <cstdint>
#include <cmath>
#ifndef ONE_LAUNCH
#define ONE_LAUNCH 1
#endif
#ifndef WT_STORES
#define WT_STORES 1
#endif
#if WT_STORES
#define ST16_WT(p, v) asm volatile("global_store_dwordx4 %0, %1, off sc1\n\ts_nop 1" :: "v"(p), "v"(v) : "memory")
#else
#define ST16_WT(p, v) (*(decltype(v)*)(p) = (v))
#endif
#if WT_STORES
#define ST16_WTB(rs, off, v) __builtin_amdgcn_raw_buffer_store_b128((v), (rs), (off), 0, 16)
#else
#define ST16_WTB(rs, off, v) __builtin_amdgcn_raw_buffer_store_b128((v), (rs), (off), 0, 0)
#endif
namespace pg8 {
#define PG8_LAS __attribute__((address_space(3)))
typedef unsigned short bf16_t;
typedef short bf16x8 __attribute__((ext_vector_type(8)));
typedef float f32x4 __attribute__((ext_vector_type(4)));
typedef unsigned u32x4 __attribute__((ext_vector_type(4)));
constexpr int BM = 256, BK = 64, HALF = 128, HTB = HALF * BK * 2  , STAGE_BYTES = 8 * HTB, NXCD = 8, WGM = 8;

__host__ __device__ __forceinline__ int lds_byte(int r, int c) { const int st = (r >> 4) * 2 + (c >> 5), rr = r & 15, cc = c & 31, ob = rr * 64 + cc * 2; return st * 1024 + (ob ^ (((ob >> 9) & 1) << 5)); }
__host__ __device__ __forceinline__ void stage_rc(int b, int& R, int& C) { const int st = b / 1024, sb = b % 1024, swz = sb ^ (((sb >> 9) & 1) << 5); R = (st >> 1) * 16 + swz / 64; C = (st & 1) * 32 + (swz % 64) / 2; }
__host__ __device__ __forceinline__ int perm32(int rho) { const int n = rho >> 4, i = rho & 15; return 8 * (i >> 2) + 4 * n + (i & 3); }

struct Unit { int pm, pn; };
struct Gemm { const bf16_t* A; const bf16_t* Bt; int M, N, K; };

struct StaticOrder {
    int nM, nN, nwg, G, c;
    __host__ __device__ void init(int M, int N, int G_, int c_) { nM = M / BM; nN = N / BM; nwg = nM * nN; G = G_; c = c_; }
    __host__ __device__ bool next(int i, Unit& u) const {
        const long L = (long)i * G + c; if (L >= nwg) return false;
        int wgid = (int)L; { const int q = nwg / NXCD, r = nwg % NXCD, xcd = wgid % NXCD, off = wgid / NXCD; wgid = (xcd < r ? xcd * (q + 1) : r * (q + 1) + (xcd - r) * q) + off; }
        const int nig = WGM * nN, gid = wgid / nig, fm = gid * WGM, gsz = (nM - fm) < WGM ? (nM - fm) : WGM;
        u.pm = fm + ((wgid % nig) % gsz); u.pn = (wgid % nig) / gsz; return true;
    }
    __device__ __forceinline__ void a_ready(const Unit&) const {}
    __device__ __forceinline__ void done(const Unit&) const {}
};

__device__ __forceinline__ unsigned cvt_pk_bf16(float lo, float hi) { unsigned r; asm volatile("v_cvt_pk_bf16_f32 %0, %1, %2" : "=v"(r) : "v"(lo), "v"(hi)); return r; }
typedef float f32x2 __attribute__((ext_vector_type(2)));
__device__ __forceinline__ f32x2 gelu_pk(f32x2 v) {
    const f32x2 av = __builtin_elementwise_abs(v), d = av * 0.2316418882f + 1.0f;
    f32x2 t; t.x = __builtin_amdgcn_rcpf(d.x); t.y = __builtin_amdgcn_rcpf(d.y);
    f32x2 q = t * 0.5307027145f + (-0.7265760135f); q = q * t + 0.7107068705f; q = q * t + (-0.142248368f); q = q * t + 0.127414796f; q = q * t;
    const f32x2 s = (v * v) * (-0.72134752044f);
    f32x2 e; e.x = __builtin_amdgcn_exp2f(s.x); e.y = __builtin_amdgcn_exp2f(s.y);
    const f32x2 m = v * (q * e), r = v - m;
    f32x2 o; o.x = v.x < 0.f ? m.x : r.x; o.y = v.y < 0.f ? m.y : r.y; return o;
}

template <int ACT  > struct EpiBf16 {
    static constexpr bool PERM = true, AFTER_DRAIN = false; static_assert(ACT == 0 || ACT == 1, "EpiBf16: ACT is 0 (none) or 1 (gelu_pk)");
    bf16_t* O; int ldc; const float* bias; int split_cols; size_t split_stride; float scale0;
    __device__ __forceinline__ void operator()(const f32x4 (&acc)[2][2][4][2], const Unit& u, int wr, int wc, int fr, int fq) const {
        const int row0 = u.pm * BM + wr * 64 + fr; int colt = u.pn * BM; bf16_t* base = O;
        float sc = 1.f; if (split_cols) { const int t = colt / split_cols; base += (size_t)t * split_stride; colt -= t * split_cols; if (t == 0) sc = scale0; }
        const int col0 = colt + wc * 32 + 8 * fq, bcol0 = u.pn * BM + wc * 32 + 8 * fq;
        f32x4 bv[2][2];
#pragma unroll
        for (int bj = 0; bj < 2; ++bj)
#pragma unroll
            for (int n = 0; n < 2; ++n) bv[bj][n] = bias ? *(const f32x4*)(bias + bcol0 + bj * HALF + 4 * n) : (f32x4){0.f, 0.f, 0.f, 0.f};
#pragma unroll
        for (int ai = 0; ai < 2; ++ai)
#pragma unroll
            for (int m = 0; m < 4; ++m) { bf16_t* rowp = base + (size_t)(row0 + ai * HALF + m * 16) * ldc + col0;
#pragma unroll
                for (int bj = 0; bj < 2; ++bj) { f32x4 v0 = acc[ai][bj][m][0] + bv[bj][0], v1 = acc[ai][bj][m][1] + bv[bj][1];
                    if (ACT == 1) { f32x2 a = gelu_pk((f32x2){v0[0], v0[1]}), b = gelu_pk((f32x2){v0[2], v0[3]}), c = gelu_pk((f32x2){v1[0], v1[1]}), d = gelu_pk((f32x2){v1[2], v1[3]});
                        v0 = (f32x4){a.x, a.y, b.x, b.y}; v1 = (f32x4){c.x, c.y, d.x, d.y}; }
                    v0 = v0 * sc; v1 = v1 * sc; u32x4 w; w.x = cvt_pk_bf16(v0[0], v0[1]); w.y = cvt_pk_bf16(v0[2], v0[3]); w.z = cvt_pk_bf16(v1[0], v1[1]); w.w = cvt_pk_bf16(v1[2], v1[3]);
                    ST16_WT(rowp + bj * HALF, w); } }
    }
};
template <class Epi, class Sched, bool ALIGN_EPI = false, bool SP2 = false>
__device__ __forceinline__ void gemm_phase(PG8_LAS unsigned char* lds, const Gemm g, const Sched& S, const Epi& E) {
    const int tid = threadIdx.x, wid = __builtin_amdgcn_readfirstlane(tid >> 6), lane = tid & 63, wr = wid >> 2, wc = wid & 3, fr = lane & 15, fq = lane >> 4;
    const int K = g.K, nt = K / BK;
    unsigned voffA[2], voffB[2];
#pragma unroll
    for (int i = 0; i < 2; ++i) { int R, C; stage_rc(tid * 16 + i * 8192, R, C); const int Rb = Epi::PERM ? ((R & ~31) + perm32(R & 31)) : R;
        voffA[i] = (unsigned)(R * K + C) * 2u; voffB[i] = (unsigned)(Rb * K + C) * 2u; }
    const size_t kstep = (size_t)(BK * 2);
    const size_t hstep = (size_t)HALF * K * 2;
    const size_t tstep = 2 * hstep;
    const unsigned ldsw = (unsigned)wid * 1024u;
    const int aoff = lds_byte(wr * 64 + fr, fq * 8), boff = lds_byte(wc * 32 + fr, fq * 8);
#define PG8_SA(b, h) (((b) * 2 + (h)) * HTB)
#define PG8_SB(b, h) ((4 + (b) * 2 + (h)) * HTB)
#define PG8_STAGE(bufoff, gbase, voff) do { _Pragma("unroll") for (int _i = 0; _i < 2; ++_i) \
        __builtin_amdgcn_global_load_lds((const unsigned*)((const char*)(gbase) + (voff)[_i]), (PG8_LAS unsigned*)(lds + (bufoff) + ldsw + _i * 8192), 16, 0, 0); } while (0)
#define PG8_LDA(dst, b, h) do { _Pragma("unroll") for (int m = 0; m < 4; ++m) _Pragma("unroll") for (int k = 0; k < 2; ++k) dst[m][k] = *(const PG8_LAS bf16x8*)(lds + PG8_SA(b, h) + aoff + m * 2048 + k * 1024); } while (0)
#define PG8_LDB(dst, b, h) do { _Pragma("unroll") for (int n = 0; n < 2; ++n) _Pragma("unroll") for (int k = 0; k < 2; ++k) dst[n][k] = *(const PG8_LAS bf16x8*)(lds + PG8_SB(b, h) + boff + n * 2048 + k * 1024); } while (0)
#define PG8_MMA(ai, bj, At, Bt) do { __builtin_amdgcn_s_setprio(1); _Pragma("unroll") for (int m = 0; m < 4; ++m) _Pragma("unroll") for (int n = 0; n < 2; ++n) _Pragma("unroll") for (int k = 0; k < 2; ++k) \
        acc[ai][bj][m][n] = __builtin_amdgcn_mfma_f32_16x16x32_bf16(Bt[n][k], At[m][k], acc[ai][bj][m][n], 0, 0, 0); __builtin_amdgcn_s_setprio(0); } while (0)
#define PG8_WAIT_V(n) asm volatile("s_waitcnt vmcnt(" #n ")" ::: "memory")
#define PG8_WAIT_L(n) asm volatile("s_waitcnt lgkmcnt(" #n ")" ::: "memory")
#define PG8_BAR __builtin_amdgcn_s_barrier()
#define PG8_SCHED __builtin_amdgcn_sched_barrier(0)
    Unit cur, nxt; int ui = 0;
    if (!S.next(0, cur)) return;
    f32x4 acc[2][2][4][2];
#pragma unroll
    for (int a = 0; a < 2; ++a)
#pragma unroll
        for (int b = 0; b < 2; ++b)
#pragma unroll
            for (int m = 0; m < 4; ++m)
#pragma unroll
                for (int n = 0; n < 2; ++n) acc[a][b][m][n] = (f32x4){0.f, 0.f, 0.f, 0.f};
    bf16x8 At[4][2], B0[2][2], B1[2][2];
    const char* cA = (const char*)g.A + (size_t)cur.pm * tstep; const char* cB = (const char*)g.Bt + (size_t)cur.pn * tstep;
    S.a_ready(cur);
    if constexpr (SP2) {
        PG8_STAGE(PG8_SB(0, 0), cB, voffB); PG8_STAGE(PG8_SB(0, 1), cB + hstep, voffB); PG8_STAGE(PG8_SA(0, 0), cA, voffA); PG8_STAGE(PG8_SA(0, 1), cA + hstep, voffA);
        if (wr == 1) PG8_BAR;
        PG8_WAIT_V(2); PG8_BAR;
        PG8_STAGE(PG8_SB(1, 0), cB + kstep, voffB); PG8_STAGE(PG8_SA(1, 0), cA + kstep, voffA); PG8_STAGE(PG8_SB(1, 1), cB + hstep + kstep, voffB);
        PG8_WAIT_V(6); PG8_BAR;
    } else {
        PG8_STAGE(PG8_SB(0, 0), cB, voffB); PG8_STAGE(PG8_SA(0, 0), cA, voffA); PG8_STAGE(PG8_SB(0, 1), cB + hstep, voffB); PG8_STAGE(PG8_SA(0, 1), cA + hstep, voffA);
        if (wr == 1) PG8_BAR;
        PG8_WAIT_V(4); PG8_BAR;
        PG8_STAGE(PG8_SB(1, 0), cB + kstep, voffB); PG8_STAGE(PG8_SA(1, 0), cA + kstep, voffA); PG8_STAGE(PG8_SB(1, 1), cB + hstep + kstep, voffB);
        PG8_WAIT_V(6); PG8_BAR;
    }
    for (;;) {
        const bool has_next = S.next(ui + 1, nxt);
        const char* nA = has_next ? (const char*)g.A + (size_t)nxt.pm * tstep : cA; const char* nB = has_next ? (const char*)g.Bt + (size_t)nxt.pn * tstep : cB;
        for (int t = 0; t < nt; t += 2) {
            const bool last = (t == nt - 2);
            const char* a1 = cA + (size_t)(t + 1) * kstep;
            const char* a2 = last ? nA : cA + (size_t)(t + 2) * kstep; const char* b2 = last ? nB : cB + (size_t)(t + 2) * kstep;
            const char* a3 = a2 + kstep; const char* b3 = b2 + kstep;
            if (last && has_next) S.a_ready(nxt);
            if constexpr (SP2) {
            PG8_LDB(B0, 0, 0); PG8_LDB(B1, 0, 1); PG8_SCHED; PG8_LDA(At, 0, 0); PG8_STAGE(PG8_SA(1, 1), a1 + hstep, voffA);
            PG8_WAIT_V(8); PG8_WAIT_L(0); PG8_BAR; PG8_MMA(0, 0, At, B0); PG8_MMA(0, 1, At, B1); PG8_BAR; PG8_SCHED;
            PG8_LDA(At, 0, 1); PG8_STAGE(PG8_SB(0, 0), b2, voffB); PG8_STAGE(PG8_SB(0, 1), b2 + hstep, voffB); PG8_STAGE(PG8_SA(0, 0), a2, voffA);
            PG8_WAIT_V(8); PG8_WAIT_L(0); PG8_BAR; PG8_MMA(1, 0, At, B0); PG8_MMA(1, 1, At, B1); PG8_BAR; PG8_SCHED;
            PG8_LDB(B0, 1, 0); PG8_LDB(B1, 1, 1); PG8_SCHED; PG8_LDA(At, 1, 0); PG8_STAGE(PG8_SA(0, 1), a2 + hstep, voffA);
            PG8_WAIT_V(8); PG8_WAIT_L(0); PG8_BAR; PG8_MMA(0, 0, At, B0); PG8_MMA(0, 1, At, B1); PG8_BAR; PG8_SCHED;
            PG8_LDA(At, 1, 1); PG8_STAGE(PG8_SB(1, 0), b3, voffB); PG8_STAGE(PG8_SB(1, 1), b3 + hstep, voffB); PG8_STAGE(PG8_SA(1, 0), a3, voffA);
            PG8_WAIT_V(8); PG8_WAIT_L(0); PG8_BAR; PG8_MMA(1, 0, At, B0); PG8_MMA(1, 1, At, B1); PG8_BAR; PG8_SCHED;
            } else {
            PG8_LDB(B0, 0, 0); PG8_SCHED; PG8_LDA(At, 0, 0); PG8_STAGE(PG8_SA(1, 1), a1 + hstep, voffA);
            PG8_WAIT_L(8); PG8_BAR; PG8_WAIT_L(0); PG8_MMA(0, 0, At, B0); PG8_BAR; PG8_SCHED;
            PG8_LDB(B1, 0, 1); PG8_STAGE(PG8_SB(0, 0), b2, voffB);
            PG8_BAR; PG8_WAIT_L(0); PG8_MMA(0, 1, At, B1); PG8_BAR;
            PG8_LDA(At, 0, 1); PG8_STAGE(PG8_SA(0, 0), a2, voffA);
            PG8_BAR; PG8_WAIT_L(0); PG8_MMA(1, 0, At, B0); PG8_BAR; PG8_SCHED;
            PG8_STAGE(PG8_SB(0, 1), b2 + hstep, voffB);
            PG8_WAIT_V(6); PG8_BAR; PG8_MMA(1, 1, At, B1); PG8_BAR;
            PG8_LDB(B0, 1, 0); PG8_SCHED; PG8_LDA(At, 1, 0); PG8_STAGE(PG8_SA(0, 1), a2 + hstep, voffA);
            PG8_WAIT_L(8); PG8_BAR; PG8_WAIT_L(0); PG8_MMA(0, 0, At, B0); PG8_BAR; PG8_SCHED;
            PG8_LDB(B1, 1, 1); PG8_STAGE(PG8_SB(1, 0), b3, voffB);
            PG8_BAR; PG8_WAIT_L(0); PG8_MMA(0, 1, At, B1); PG8_BAR;
            PG8_LDA(At, 1, 1); PG8_STAGE(PG8_SA(1, 0), a3, voffA);
            PG8_BAR; PG8_WAIT_L(0); PG8_MMA(1, 0, At, B0); PG8_BAR; PG8_SCHED;
            PG8_STAGE(PG8_SB(1, 1), b3 + hstep, voffB);
            PG8_WAIT_V(6); PG8_BAR; PG8_MMA(1, 1, At, B1); PG8_BAR;
            }
        }
        if constexpr (ALIGN_EPI) { if (wr == 0) PG8_BAR; }
        if constexpr (!Epi::AFTER_DRAIN) { E(acc, cur, wr, wc, fr, fq); S.done(cur); }
        if (!has_next) break;
#pragma unroll
        for (int a = 0; a < 2; ++a)
#pragma unroll
            for (int b = 0; b < 2; ++b)
#pragma unroll
                for (int m = 0; m < 4; ++m)
#pragma unroll
                    for (int n = 0; n < 2; ++n) acc[a][b][m][n] = (f32x4){0.f, 0.f, 0.f, 0.f};
        cur = nxt; cA = nA; cB = nB; ++ui;
        if constexpr (ALIGN_EPI) { if (wr == 1) PG8_BAR; }
    }
    PG8_WAIT_V(0);
    if constexpr (!ALIGN_EPI) { if (wr == 0) PG8_BAR; }
    PG8_BAR;
    if constexpr (Epi::AFTER_DRAIN) { E.fused(acc, cur, wr, wc, fr, fq, lds, wid, lane); S.done(cur); }
#undef PG8_SA
#undef PG8_SB
#undef PG8_STAGE
#undef PG8_LDA
#undef PG8_LDB
#undef PG8_MMA
#undef PG8_WAIT_V
#undef PG8_WAIT_L
#undef PG8_BAR
#undef PG8_SCHED
}
}
#define GAS __attribute__((address_space(1)))
#define LAS __attribute__((address_space(3)))
typedef unsigned short bf16;
typedef unsigned v4u __attribute__((ext_vector_type(4)));
typedef float f32x4 __attribute__((ext_vector_type(4)));
typedef short bf16x8 __attribute__((ext_vector_type(8)));
typedef GAS unsigned gu32;
typedef GAS unsigned long long gu64;
#define RLX_AGENT __ATOMIC_RELAXED, __HIP_MEMORY_SCOPE_AGENT
#define LDS_WAIT() asm volatile("s_waitcnt lgkmcnt(0)" ::: "memory")
#define VM_WAIT() asm volatile("s_waitcnt vmcnt(0)" ::: "memory")
__device__ __forceinline__ unsigned long long rt() { return __builtin_amdgcn_s_memrealtime(); }
__device__ __forceinline__ unsigned f2bf(float f) { unsigned u = __builtin_bit_cast(unsigned, f); return (u + 0x7fffu + ((u >> 16) & 1u)) >> 16; }
__device__ __forceinline__ unsigned pk2(float lo, float hi) { return f2bf(lo) | (f2bf(hi) << 16); }

#define XB_TMO      128
#define XB_XCNT(j)  (256  + 64 * (j))
#define XB_XSUB(j)  (1280 + 64 * (j))
#define XB_XGEN(j)  (2304 + 64 * (j))
#define XB_TOP      3328
#define XB_TOPGEN   3392
#define XCD_BAR_WORDS 3456
#define XB_SPIN_CAP (1u << 18)

__device__ __forceinline__ unsigned xb_ld(unsigned* p)              { return __hip_atomic_load(p, __ATOMIC_RELAXED, __HIP_MEMORY_SCOPE_AGENT); }
__device__ __forceinline__ unsigned xb_add(unsigned* p, unsigned v) { return __hip_atomic_fetch_add(p, v, __ATOMIC_RELAXED, __HIP_MEMORY_SCOPE_AGENT); }
__device__ __forceinline__ unsigned xb_xcc_id() { return (unsigned)__builtin_amdgcn_s_getreg((3 << 11) | 20) & 0xFu; }
#define XB_SPIN(cond, bar) do { unsigned _sp = 0; while (cond) { __builtin_amdgcn_s_sleep(1); \
    if ((++_sp & 255u) == 0u) { if (xb_ld(&(bar)[XB_TMO])) break; if (_sp > XB_SPIN_CAP) { atomicAdd(&(bar)[XB_TMO], 1u); break; } } } } while (0)

struct XcdBarrier {
    unsigned* bar; unsigned x;
    volatile LAS unsigned* st;
};

__device__ __forceinline__ XcdBarrier xcd_barrier_post(unsigned* bar, volatile LAS unsigned* st) {
    XcdBarrier b; b.bar = bar; b.x = xb_xcc_id(); b.st = st;
    if (threadIdx.x == 0) (void)xb_add(&bar[XB_XCNT(b.x)], 1u);
    return b;
}
__device__ __forceinline__ void xcd_barrier_complete(unsigned* bar, unsigned x, unsigned& nloc, unsigned& nx) {
    const unsigned G = gridDim.x * gridDim.y * gridDim.z;
    unsigned sum, cnt, mine, sp = 0u;
    for (;;) {
        sum = 0u; cnt = 0u; mine = 0u;
#pragma unroll
        for (unsigned j = 0; j < 16; ++j) { const unsigned c = xb_ld(&bar[XB_XCNT(j)]); sum += c; cnt += (c > 0u) ? 1u : 0u; mine = (j == x) ? c : mine; }
        if (sum == G) break;
        __builtin_amdgcn_s_sleep(1);
        if ((++sp & 255u) == 0u) { if (xb_ld(&bar[XB_TMO])) break; if (sp > XB_SPIN_CAP) { atomicAdd(&bar[XB_TMO], 1u); break; } }
    }
    nloc = mine > 0u ? mine : 1u; nx = cnt > 0u ? cnt : 1u;
}

__device__ __forceinline__ void xcd_barrier(const XcdBarrier& b) {
    asm volatile("s_waitcnt vmcnt(0)" ::: "memory");
    __syncthreads();
    if (threadIdx.x == 0) {
        unsigned* bar = b.bar;
        __builtin_amdgcn_s_waitcnt(0);
        unsigned nloc = b.st[0], nx = b.st[1];
        if (nloc == 0u) { xcd_barrier_complete(bar, b.x, nloc, nx); b.st[0] = nloc; b.st[1] = nx; }
        const unsigned old = xb_add(&bar[XB_XSUB(b.x)], 1u);
        const unsigned gen = old / nloc;
        if (old + 1u == (gen + 1u) * nloc) {
            __builtin_amdgcn_fence(__ATOMIC_RELEASE, "agent");
            asm volatile("s_waitcnt vmcnt(0)" ::: "memory");
            const unsigned og = xb_add(&bar[XB_TOP], 1u);
            const unsigned tg = og / nx;
            if (og + 1u == (tg + 1u) * nx) xb_add(&bar[XB_TOPGEN], 1u);
            else XB_SPIN(xb_ld(&bar[XB_TOPGEN]) == tg, bar);
            __builtin_amdgcn_fence(__ATOMIC_ACQUIRE, "agent");
            xb_add(&bar[XB_XGEN(b.x)], 1u);
            asm volatile("s_waitcnt vmcnt(0)" ::: "memory");
        } else {
            XB_SPIN(xb_ld(&bar[XB_XGEN(b.x)]) == gen, bar);
            __builtin_amdgcn_fence(__ATOMIC_ACQUIRE, "agent");
            asm volatile("s_waitcnt vmcnt(0)" ::: "memory");
        }
    }
    __syncthreads();
}

#if ONE_LAUNCH
#define GRID_SYNC() cooperative_groups::this_grid().sync()
#else
#define GRID_SYNC() do {} while (0)
#endif

constexpr int BATCH = 8, SEQ = 4096, DM = 1024, T = BATCH * SEQ;
constexpr int D_IN = 3584, D_MIX = 1536, D_Q = 2048;
constexpr int LCH = 64, NCHUNK = SEQ / LCH;
constexpr float LN_EPS = 1e-5f, RMS_EPS = 1e-6f;
constexpr float ALPHA = 1.189207115002721f;
constexpr int NWAVES = 8, NTHREADS = 512;

constexpr size_t MiB = 1u << 20;
constexpr size_t WS_CTL = 0, CTL_ZERO_BYTES = 64 * 1024;
constexpr size_t WS_WIN = 1 * MiB;
constexpr size_t WS_WOUT = 8 * MiB;
constexpr size_t WS_WQ = 11 * MiB;
constexpr size_t WS_GW = 15 * MiB;
constexpr size_t WS_K1 = 16 * MiB;
constexpr size_t WS_K2 = 16 * MiB + 64 * 1024;
constexpr size_t WS_CARRY = 18 * MiB;
constexpr size_t WS_SUMM = 24 * MiB;
constexpr size_t WS_H0 = 32 * MiB;
constexpr size_t WS_H1 = 32 * MiB;
constexpr size_t WS_XR = 96 * MiB;
constexpr size_t WS_PRE1 = 96 * MiB;
constexpr size_t WS_GATE = 160 * MiB;
constexpr size_t WS_CCX = 224 * MiB;
constexpr size_t WS_U8 = 416 * MiB;
constexpr size_t WS_V8 = 432 * MiB;
#ifndef TABLE_FP4
#define TABLE_FP4 1
#endif
#if TABLE_FP4
constexpr float U_SCALE = 64.f, V_SCALE = 3.3635857f;
constexpr float U_STEP = 0.3352f / 32.f;
constexpr int ROWB = 512;
#else
constexpr float U_SCALE = 256.f, V_SCALE = 16.f;
constexpr int ROWB = 1024;
#endif
constexpr size_t WS_MIX = 288 * MiB;
constexpr size_t WS_Q = 288 * MiB;
constexpr size_t WS_IDX = 448 * MiB;
constexpr size_t WS_G = 464 * MiB;
constexpr size_t WS_DOT = 480 * MiB;
constexpr size_t WS_END = 512 * MiB;

constexpr int LDS_BYTES = 147456;
constexpr int MISC_OFF = 143360;

typedef unsigned v2u __attribute__((ext_vector_type(2)));
typedef __bf16 bf16x2 __attribute__((ext_vector_type(2)));

typedef float f32x2_ __attribute__((ext_vector_type(2)));
__device__ __forceinline__ unsigned pk2h(float lo, float hi) { const f32x2_ v = {lo, hi}; const bf16x2 b = __builtin_convertvector(v, bf16x2); return __builtin_bit_cast(unsigned, b); }
#define pk2(lo, hi) pk2h((lo), (hi))
#define f2bf(x) (pk2h((x), 0.f) & 0xffffu)
__device__ __forceinline__ float bflo(unsigned w) { return __builtin_bit_cast(float, w << 16); }
__device__ __forceinline__ float bfhi(unsigned w) { return __builtin_bit_cast(float, w & 0xffff0000u); }
__device__ __forceinline__ float wave_sum(float v) {
#pragma unroll
    for (int o = 1; o < 64; o <<= 1) v += __shfl_xor(v, o);
    return v;
}
__device__ __forceinline__ float dot2_bf16(unsigned w, unsigned x, float acc) { return __builtin_amdgcn_fdot2_f32_bf16(__builtin_bit_cast(bf16x2, w), __builtin_bit_cast(bf16x2, x), acc, false); }
__device__ __forceinline__ float sigmoidf_(float x) { return __builtin_amdgcn_rcpf(1.0f + __builtin_amdgcn_exp2f(-1.4426950408889634f * x)); }
__device__ __forceinline__ float gelu_tanh(float x) { const float u = 0.7978845608028654f * (x + 0.044715f * x * x * x); return 0.5f * x * (1.0f + tanhf(u)); }
__device__ __forceinline__ float gelu_erf(float x) { return 0.5f * x * (1.0f + erff(x * 0.7071067811865476f)); }

struct Args { const float* in[24]; float* out; unsigned char* ws; int ph_lo, ph_hi; };

template <bool REMAP = false>
__device__ __forceinline__ void p0_transpose_item(const float* W, int K, int N, bf16* WT, LAS float* scr, int item, int lane, float wscale = 1.0f) {
    const int nblk = N / 32, kb = item / nblk, nb = item % nblk, k0 = 64 * kb, n0 = 32 * nb;
    int ns = n0;
    if (REMAP && n0 >= 2560) { const int j = (n0 - 2560) >> 8, w = (n0 - 2560) & 255; ns = (w < 128) ? 2560 + 128 * j + w : 3072 + 128 * j + (w - 128); }
#pragma unroll 8
    for (int i = 0; i < 32; ++i) { const int kk = 2 * i + (lane >> 5); scr[kk * 33 + (lane & 31)] = wscale * W[(size_t)(k0 + kk) * N + ns + (lane & 31)]; }
    asm volatile("s_waitcnt lgkmcnt(0)" ::: "memory");
    const int c = lane & 7;
#pragma unroll
    for (int j = 0; j < 4; ++j) { const int n = (lane >> 3) + 8 * j; const LAS float* s = scr + (8 * c) * 33 + n;
        v4u o; o.x = pk2(s[0 * 33], s[1 * 33]); o.y = pk2(s[2 * 33], s[3 * 33]); o.z = pk2(s[4 * 33], s[5 * 33]); o.w = pk2(s[6 * 33], s[7 * 33]);
        ST16_WT(WT + (size_t)(n0 + n) * K + k0 + 8 * c, o); }
    asm volatile("s_waitcnt lgkmcnt(0)" ::: "memory");
}
__device__ __forceinline__ void ln_row_bf16(const float* xrow, const float* g, const float* b, bf16* orow, int lane) {
    f32x4 v[4]; float s = 0.f;
#pragma unroll
    for (int j = 0; j < 2; ++j) { v[2 * j] = *(const f32x4*)(xrow + 512 * j + 8 * lane); v[2 * j + 1] = *(const f32x4*)(xrow + 512 * j + 8 * lane + 4); }
#pragma unroll
    for (int j = 0; j < 4; ++j) s += (v[j].x + v[j].y) + (v[j].z + v[j].w);
    const float mean = wave_sum(s) * (1.f / DM); float s2 = 0.f;
#pragma unroll
    for (int j = 0; j < 4; ++j) { v[j] = v[j] - mean; s2 += (v[j].x * v[j].x + v[j].y * v[j].y) + (v[j].z * v[j].z + v[j].w * v[j].w); }
    const float rstd = __builtin_amdgcn_rsqf(wave_sum(s2) * (1.f / DM) + LN_EPS);
#pragma unroll
    for (int j = 0; j < 2; ++j) { const int col = 512 * j + 8 * lane;
        const f32x4 g0 = *(const f32x4*)(g + col), g1 = *(const f32x4*)(g + col + 4), b0 = *(const f32x4*)(b + col), b1 = *(const f32x4*)(b + col + 4);
        const f32x4 o0 = v[2 * j] * rstd * g0 + b0, o1 = v[2 * j + 1] * rstd * g1 + b1;
        v4u w; w.x = pk2(o0.x, o0.y); w.y = pk2(o0.z, o0.w); w.z = pk2(o1.x, o1.y); w.w = pk2(o1.z, o1.w);
        ST16_WT(orow + col, w); }
}
__device__ __forceinline__ void ln_row_bf16_b(const bf16* xrow, const float* g, const float* b, bf16* orow, int lane) {
    const v4u a0 = *(const v4u*)(xrow + 8 * lane), a1 = *(const v4u*)(xrow + 512 + 8 * lane);
    float v[16]; float s = 0.f;
#pragma unroll
    for (int i = 0; i < 4; ++i) { v[2 * i] = bflo(a0[i]); v[2 * i + 1] = bfhi(a0[i]); v[8 + 2 * i] = bflo(a1[i]); v[8 + 2 * i + 1] = bfhi(a1[i]); }
#pragma unroll
    for (int i = 0; i < 16; ++i) s += v[i];
    const float mean = wave_sum(s) * (1.f / DM); float s2 = 0.f;
#pragma unroll
    for (int i = 0; i < 16; ++i) { v[i] -= mean; s2 += v[i] * v[i]; }
    const float rstd = __builtin_amdgcn_rsqf(wave_sum(s2) * (1.f / DM) + LN_EPS);
#pragma unroll
    for (int hf = 0; hf < 2; ++hf) { const int col = hf * 512 + 8 * lane; const f32x4 g0 = *(const f32x4*)(g + col), g1 = *(const f32x4*)(g + col + 4), b0 = *(const f32x4*)(b + col), b1 = *(const f32x4*)(b + col + 4);
        v4u o; o.x = pk2(v[hf * 8 + 0] * rstd * g0[0] + b0[0], v[hf * 8 + 1] * rstd * g0[1] + b0[1]); o.y = pk2(v[hf * 8 + 2] * rstd * g0[2] + b0[2], v[hf * 8 + 3] * rstd * g0[3] + b0[3]);
        o.z = pk2(v[hf * 8 + 4] * rstd * g1[0] + b1[0], v[hf * 8 + 5] * rstd * g1[1] + b1[1]); o.w = pk2(v[hf * 8 + 6] * rstd * g1[2] + b1[2], v[hf * 8 + 7] * rstd * g1[3] + b1[3]);
        ST16_WT(orow + col, o); }
}
#ifndef LN0_PIPE
#define LN0_PIPE 1
#endif
#ifndef LN1_PIPE
#define LN1_PIPE 1
#endif
__device__ __forceinline__ void ln_rows_f32(const float* X, const float* g, const float* b, bf16* O, int gw, int NGW, int lane) {
    const __amdgpu_buffer_rsrc_t ors = __builtin_amdgcn_make_buffer_rsrc((void*)O, 0, (int)((size_t)T * DM * 2), 0x00020000);
    f32x4 gg[4], bb[4];
#pragma unroll
    for (int j = 0; j < 2; ++j) { const int col = 512 * j + 8 * lane; gg[2 * j] = *(const f32x4*)(g + col); gg[2 * j + 1] = *(const f32x4*)(g + col + 4); bb[2 * j] = *(const f32x4*)(b + col); bb[2 * j + 1] = *(const f32x4*)(b + col + 4); }
    auto ld = [&](f32x4 (&v)[4], int m) { const float* xr = X + (size_t)(m < T ? m : gw) * DM;
#pragma unroll
        for (int j = 0; j < 2; ++j) { v[2 * j] = *(const f32x4*)(xr + 512 * j + 8 * lane); v[2 * j + 1] = *(const f32x4*)(xr + 512 * j + 8 * lane + 4); } };
    auto fin = [&](f32x4 (&v)[4], int m) { const int mr = (m < T ? m : gw); float s = 0.f;
#pragma unroll
        for (int j = 0; j < 4; ++j) s += (v[j].x + v[j].y) + (v[j].z + v[j].w);
        const float mean = wave_sum(s) * (1.f / DM); float s2 = 0.f;
#pragma unroll
        for (int j = 0; j < 4; ++j) { v[j] = v[j] - mean; s2 += (v[j].x * v[j].x + v[j].y * v[j].y) + (v[j].z * v[j].z + v[j].w * v[j].w); }
        const float rstd = __builtin_amdgcn_rsqf(wave_sum(s2) * (1.f / DM) + LN_EPS);
#pragma unroll
        for (int j = 0; j < 2; ++j) { const f32x4 o0 = v[2 * j] * rstd * gg[2 * j] + bb[2 * j], o1 = v[2 * j + 1] * rstd * gg[2 * j + 1] + bb[2 * j + 1];
            v4u w; w.x = pk2(o0.x, o0.y); w.y = pk2(o0.z, o0.w); w.z = pk2(o1.x, o1.y); w.w = pk2(o1.z, o1.w);
            ST16_WTB(ors, (mr * DM + 512 * j + 8 * lane) * 2, w); } };
    f32x4 r0[4], r1[4], r2[4];
    int m = gw; ld(r0, m); ld(r1, m + NGW);
#define SB_ __builtin_amdgcn_sched_barrier(0)
    SB_;
    for (; m < T; m += 3 * NGW) { ld(r2, m + 2 * NGW); SB_; fin(r0, m); SB_; ld(r0, m + 3 * NGW); SB_; fin(r1, m + NGW); SB_; ld(r1, m + 4 * NGW); SB_; fin(r2, m + 2 * NGW); SB_; }
}
__device__ __forceinline__ void ln_rows_bf16(const bf16* X, const float* g, const float* b, bf16* O, int gw, int NGW, int lane) {
    const __amdgpu_buffer_rsrc_t ors = __builtin_amdgcn_make_buffer_rsrc((void*)O, 0, (int)((size_t)T * DM * 2), 0x00020000);
    f32x4 gg[4], bb[4];
#pragma unroll
    for (int j = 0; j < 2; ++j) { const int col = 512 * j + 8 * lane; gg[2 * j] = *(const f32x4*)(g + col); gg[2 * j + 1] = *(const f32x4*)(g + col + 4); bb[2 * j] = *(const f32x4*)(b + col); bb[2 * j + 1] = *(const f32x4*)(b + col + 4); }
    struct Row { v4u a0, a1; };
    auto ld = [&](Row& r, int m) { const bf16* xr = X + (size_t)(m < T ? m : gw) * DM; r.a0 = *(const v4u*)(xr + 8 * lane); r.a1 = *(const v4u*)(xr + 512 + 8 * lane); };
    auto fin = [&](const Row& r, int m) { const int mr = (m < T ? m : gw); float v[16]; float s = 0.f;
#pragma unroll
        for (int i = 0; i < 4; ++i) { v[2 * i] = bflo(r.a0[i]); v[2 * i + 1] = bfhi(r.a0[i]); v[8 + 2 * i] = bflo(r.a1[i]); v[8 + 2 * i + 1] = bfhi(r.a1[i]); }
#pragma unroll
        for (int i = 0; i < 16; ++i) s += v[i];
        const float mean = wave_sum(s) * (1.f / DM); float s2 = 0.f;
#pragma unroll
        for (int i = 0; i < 16; ++i) { v[i] -= mean; s2 += v[i] * v[i]; }
        const float rstd = __builtin_amdgcn_rsqf(wave_sum(s2) * (1.f / DM) + LN_EPS);
#pragma unroll
        for (int hf = 0; hf < 2; ++hf) { const f32x4 g0 = gg[2 * hf], g1 = gg[2 * hf + 1], b0 = bb[2 * hf], b1 = bb[2 * hf + 1];
            v4u o; o.x = pk2(v[hf * 8 + 0] * rstd * g0[0] + b0[0], v[hf * 8 + 1] * rstd * g0[1] + b0[1]); o.y = pk2(v[hf * 8 + 2] * rstd * g0[2] + b0[2], v[hf * 8 + 3] * rstd * g0[3] + b0[3]);
            o.z = pk2(v[hf * 8 + 4] * rstd * g1[0] + b1[0], v[hf * 8 + 5] * rstd * g1[1] + b1[1]); o.w = pk2(v[hf * 8 + 6] * rstd * g1[2] + b1[2], v[hf * 8 + 7] * rstd * g1[3] + b1[3]);
            ST16_WTB(ors, (mr * DM + hf * 512 + 8 * lane) * 2, o); } };
    Row r0, r1, r2, r3;
    int m = gw; ld(r0, m); ld(r1, m + NGW); ld(r2, m + 2 * NGW);
    SB_;
    for (; m < T; m += 4 * NGW) { ld(r3, m + 3 * NGW); SB_; fin(r0, m); SB_; ld(r0, m + 4 * NGW); SB_; fin(r1, m + NGW); SB_; ld(r1, m + 5 * NGW); SB_; fin(r2, m + 2 * NGW); SB_; ld(r2, m + 6 * NGW); SB_; fin(r3, m + 3 * NGW); SB_; }
}
__device__ __forceinline__ void phase0(const Args& a, LAS unsigned char* lds, int vcu, int G, int wave, int lane) {
    unsigned char* ws = a.ws;
    LAS float* scr = (LAS float*)(lds + wave * 16384);
    const int gw = vcu * NWAVES + wave, NGW = G * NWAVES;
    constexpr int I_IN = (DM / 64) * (D_IN / 32), I_OUT = (D_MIX / 64) * (DM / 32), I_Q = (DM / 64) * (D_Q / 32), I_G = 32 * 8;
    constexpr int NITEMS = I_IN + I_OUT + I_Q + I_G;
    for (int it = gw; it < NITEMS; it += NGW) {
        int r = it;
        if (r < I_IN) { p0_transpose_item<true>(a.in[3], DM, D_IN, (bf16*)(ws + WS_WIN), scr, r, lane); continue; } r -= I_IN;
        if (r < I_OUT) { p0_transpose_item(a.in[14], D_MIX, DM, (bf16*)(ws + WS_WOUT), scr, r, lane); continue; } r -= I_OUT;
        if (r < I_Q) { p0_transpose_item(a.in[17], DM, D_Q, (bf16*)(ws + WS_WQ), scr, r, lane); continue; } r -= I_Q;
        { const int blk = r >> 3, sub = r & 7;
          const int d = blk >> 4, which = (blk >> 3) & 1, h = blk & 7;
          const float* W = (which ? a.in[8] : a.in[6]) + (size_t)(d * 8 + h) * 16384;
          p0_transpose_item(W, 128, 128, (bf16*)(ws + WS_GW) + (size_t)blk * 16384, scr, sub, lane, -1.4426950408889634f); }
    }
    { const int gt = gw * 64 + lane, NGT = NGW * 64;
      for (int i = gt; i < 2 * 16384; i += NGT) { const float v = (i < 16384) ? a.in[18][i] : a.in[19][i - 16384]; bf16* dst = (i < 16384) ? (bf16*)(ws + WS_K1) + i : (bf16*)(ws + WS_K2) + (i - 16384); *dst = (bf16)f2bf(v); } }
#if LN0_PIPE
    ln_rows_f32(a.in[0], a.in[1], a.in[2], (bf16*)(ws + WS_H0), gw, NGW, lane);
#else
    for (int m = gw; m < T; m += NGW) ln_row_bf16(a.in[0] + (size_t)m * DM, a.in[1], a.in[2], (bf16*)(ws + WS_H0) + (size_t)m * DM, lane);
#endif
}

struct EpiIn {
    static constexpr bool PERM = true, AFTER_DRAIN = false;
    bf16 *XR, *GATE, *MIX, *CCX;
    __device__ __forceinline__ void operator()(const pg8::f32x4 (&acc)[2][2][4][2], const pg8::Unit& u, int wr, int wc, int fr, int fq) const {
        const int row0 = u.pm * 256 + wr * 64 + fr; const int pn = u.pn;
        bf16* base; int ldc, colt;
        if (pn < 4) { base = XR; ldc = 1024; colt = pn * 256; }
        else if (pn < 8) { base = GATE; ldc = 1024; colt = (pn - 4) * 256; }
        else if (pn < 10) { base = MIX; ldc = 1536; colt = 1024 + (pn - 8) * 256; }
        else {
            const int cc0 = (pn - 10) * 128 + wc * 32 + 8 * fq;
#pragma unroll
            for (int ai = 0; ai < 2; ++ai)
#pragma unroll
                for (int m = 0; m < 4; ++m) { const pg8::f32x4 p0 = acc[ai][0][m][0] * acc[ai][1][m][0], p1 = acc[ai][0][m][1] * acc[ai][1][m][1];
                    pg8::u32x4 w; w.x = pg8::cvt_pk_bf16(p0[0], p0[1]); w.y = pg8::cvt_pk_bf16(p0[2], p0[3]); w.z = pg8::cvt_pk_bf16(p1[0], p1[1]); w.w = pg8::cvt_pk_bf16(p1[2], p1[3]);
                    ST16_WT(CCX + (size_t)(row0 + ai * 128 + m * 16) * 512 + cc0, w); }
            return; }
        const int col0 = colt + wc * 32 + 8 * fq;
#pragma unroll
        for (int ai = 0; ai < 2; ++ai)
#pragma unroll
            for (int m = 0; m < 4; ++m) { bf16* rowp = base + (size_t)(row0 + ai * 128 + m * 16) * ldc + col0;
#pragma unroll
                for (int bj = 0; bj < 2; ++bj) { const pg8::f32x4 v0 = acc[ai][bj][m][0], v1 = acc[ai][bj][m][1];
                    pg8::u32x4 w; w.x = pg8::cvt_pk_bf16(v0[0], v0[1]); w.y = pg8::cvt_pk_bf16(v0[2], v0[3]); w.z = pg8::cvt_pk_bf16(v1[0], v1[1]); w.w = pg8::cvt_pk_bf16(v1[2], v1[3]);
                    ST16_WT(rowp + bj * 128, w); } }
    }
};
struct EpiPre {
    static constexpr bool PERM = true, AFTER_DRAIN = false;
    const bf16* H0; bf16* PRE;
    __device__ __forceinline__ void operator()(const pg8::f32x4 (&acc)[2][2][4][2], const pg8::Unit& u, int wr, int wc, int fr, int fq) const {
        const int row0 = u.pm * 256 + wr * 64 + fr, col0 = u.pn * 256 + wc * 32 + 8 * fq;
#pragma unroll
        for (int ai = 0; ai < 2; ++ai)
#pragma unroll
            for (int m = 0; m < 4; ++m) { const size_t ro = (size_t)(row0 + ai * 128 + m * 16) * DM + col0;
#pragma unroll
                for (int bj = 0; bj < 2; ++bj) { const v4u hw = *(const v4u*)(H0 + ro + bj * 128);
                    const pg8::f32x4 v0 = acc[ai][bj][m][0], v1 = acc[ai][bj][m][1];
                    v4u o; o.x = pk2(v0[0] + ALPHA * bflo(hw.x), v0[1] + ALPHA * bfhi(hw.x)); o.y = pk2(v0[2] + ALPHA * bflo(hw.y), v0[3] + ALPHA * bfhi(hw.y));
                    o.z = pk2(v1[0] + ALPHA * bflo(hw.z), v1[1] + ALPHA * bfhi(hw.z)); o.w = pk2(v1[2] + ALPHA * bflo(hw.w), v1[3] + ALPHA * bfhi(hw.w));
                    ST16_WT(PRE + ro + bj * 128, o); } }
    }
};

constexpr size_t TAB_GROUPS = (size_t)16384 * 1024 / 16;
#if TABLE_FP4
struct TabGroup { f32x4 v[4]; };
__device__ __forceinline__ void tab_load(TabGroup& g, const Args& a, size_t i) {
    const bool second = i >= TAB_GROUPS; const float* src = (second ? a.in[21] : a.in[20]) + (second ? i - TAB_GROUPS : i) * 16;
#pragma unroll
    for (int q = 0; q < 4; ++q) g.v[q] = *(const f32x4*)(src + 4 * q);
}
__device__ __forceinline__ void tab_store(const TabGroup& g, const Args& a, size_t i) {
    const bool second = i >= TAB_GROUPS; const size_t j = second ? i - TAB_GROUPS : i;
    unsigned char* dst = a.ws + (second ? WS_V8 : WS_U8) + j * 8;
    v2u o;
    if (second) {
#pragma unroll
        for (int q = 0; q < 2; ++q) { unsigned w = 0u; const f32x4 v0 = g.v[2 * q] * V_SCALE, v1 = g.v[2 * q + 1] * V_SCALE;
            w = __builtin_amdgcn_cvt_scalef32_pk_fp4_f32(w, fminf(fmaxf(v0[0], -6.f), 6.f), fminf(fmaxf(v0[1], -6.f), 6.f), 1.0f, 0);
            w = __builtin_amdgcn_cvt_scalef32_pk_fp4_f32(w, fminf(fmaxf(v0[2], -6.f), 6.f), fminf(fmaxf(v0[3], -6.f), 6.f), 1.0f, 1);
            w = __builtin_amdgcn_cvt_scalef32_pk_fp4_f32(w, fminf(fmaxf(v1[0], -6.f), 6.f), fminf(fmaxf(v1[1], -6.f), 6.f), 1.0f, 2);
            w = __builtin_amdgcn_cvt_scalef32_pk_fp4_f32(w, fminf(fmaxf(v1[2], -6.f), 6.f), fminf(fmaxf(v1[3], -6.f), 6.f), 1.0f, 3);
            o[q] = w; }
    } else {
#pragma unroll
        for (int q = 0; q < 2; ++q) { unsigned w = 0u;
#pragma unroll
            for (int e = 0; e < 8; ++e) { const float fv = floorf(g.v[2 * q + (e >> 2)][e & 3] * (1.0f / U_STEP)); const int qi = (int)fminf(fmaxf(fv, -8.f), 7.f); w |= ((unsigned)qi & 15u) << (4 * e); }
            o[q] = w; }
    }
    *(v2u*)dst = o;
}
#endif
#ifndef P2_EARLY1
#define P2_EARLY1 1
#endif
constexpr int ST_PITCH = 272;
constexpr int ST_TILE = 64 * ST_PITCH;
constexpr int A8_PITCH = 144, A8_TILE = 64 * A8_PITCH;
constexpr int P2_XRT = 0, P2_XC = 18432  , P2_STA = 55296  , P2_STS = P2_STA + 2 * A8_TILE;
constexpr int P2_XRT2 = P2_STS + ST_TILE;
static_assert(P2_XRT2 + 70 * 256 <= 143360, "P2 LDS");
constexpr int XC_PITCH = 272;
struct P2Const { float w0[4], w1[4], b0, b1, bav, bxv, sp; };
__device__ __forceinline__ void p2_load_const(P2Const& k, const Args& a, int d, int h, int tid, int wave, int lane) {
    const int gch2 = h * 128 + 2 * (tid & 63);
#pragma unroll
    for (int t = 0; t < 4; ++t) { k.w0[t] = a.in[4][(d * 4 + t) * DM + gch2]; k.w1[t] = a.in[4][(d * 4 + t) * DM + gch2 + 1]; }
    k.b0 = a.in[5][d * DM + gch2]; k.b1 = a.in[5][d * DM + gch2 + 1];
    const int gch = h * 128 + 16 * wave + (lane & 15);
    k.bav = -1.4426950408889634f * a.in[7][d * DM + gch]; k.bxv = -1.4426950408889634f * a.in[9][d * DM + gch];
    k.sp = -8.0f * 1.4426950408889634f * log1pf(__expf(-a.in[10][d * DM + gch]));
}
template <int D>
__device__ __forceinline__ void p2_conv(const P2Const& k, LAS unsigned char* lds, const LAS unsigned char* XRT, int tid) {
    LAS unsigned char* XC = lds + P2_XC + D * 18432;
    { const int ch2 = tid & 63, tq = tid >> 6; const int rbase = tq * 8 + (D ? 3 : 0);
      unsigned xw[11];
#pragma unroll
      for (int i = 0; i < 11; ++i) xw[i] = *(const LAS unsigned*)(XRT + (rbase + i) * 256 + ch2 * 4);
#pragma unroll
      for (int i = 0; i < 8; ++i) { float s0 = k.b0, s1 = k.b1;
#pragma unroll
          for (int t = 0; t < 4; ++t) { s0 += k.w0[t] * bflo(xw[i + t]); s1 += k.w1[t] * bfhi(xw[i + t]); }
          *(LAS unsigned*)(XC + (tq * 8 + i) * XC_PITCH + ch2 * 4) = pk2(s0, s1); } }
}
__device__ __forceinline__ void p2_load_bfrag(bf16x8 (&bA)[4], bf16x8 (&bX)[4], const bf16* GW, int d, int h, int wave, int lane) {
    const bf16* gwa = GW + (size_t)((d * 2 + 0) * 8 + h) * 16384 + (16 * wave + (lane & 15)) * 128 + 8 * (lane >> 4);
    const bf16* gwx = GW + (size_t)((d * 2 + 1) * 8 + h) * 16384 + (16 * wave + (lane & 15)) * 128 + 8 * (lane >> 4);
#pragma unroll
    for (int ks = 0; ks < 4; ++ks) { bA[ks] = *(const bf16x8*)(gwa + ks * 32); bX[ks] = *(const bf16x8*)(gwx + ks * 32); }
}
template <int D, class Mid>
__device__ __forceinline__ void p2_dir(const P2Const& k, LAS unsigned char* lds, float (&hf)[4][4],
                                       bf16x8 (&bA)[4], bf16x8 (&bX)[4], Mid&& mid, float& sum_p, float& sum_h, int wave, int lane) {
    LAS unsigned char* XC = lds + P2_XC + D * 18432; LAS unsigned char* STA = lds + P2_STA + D * A8_TILE; LAS unsigned char* STS = lds + P2_STS;
    const int q = lane >> 4, r = lane & 15, ch = 16 * wave + r;
    float av[4][4], uv[4][4];
    { pg8::f32x4 accr[4], acci[4];
#pragma unroll
      for (int m = 0; m < 4; ++m) { accr[m] = (pg8::f32x4){k.bav, k.bav, k.bav, k.bav}; acci[m] = (pg8::f32x4){k.bxv, k.bxv, k.bxv, k.bxv}; }
#pragma unroll
      for (int ks = 0; ks < 4; ++ks)
#pragma unroll
          for (int m = 0; m < 4; ++m) { const bf16x8 af = *(const LAS bf16x8*)(XC + (16 * m + r) * XC_PITCH + (ks * 32 + 8 * q) * 2);
              accr[m] = __builtin_amdgcn_mfma_f32_16x16x32_bf16(af, bA[ks], accr[m], 0, 0, 0);
              acci[m] = __builtin_amdgcn_mfma_f32_16x16x32_bf16(af, bX[ks], acci[m], 0, 0, 0); }
#pragma unroll
      for (int m = 0; m < 4; ++m)
#pragma unroll
          for (int j = 0; j < 4; ++j) { const int tt = 16 * m + 4 * q + j;
              const float ar = accr[m][j], ai = acci[m][j];
              const float rg = __builtin_amdgcn_rcpf(1.0f + __builtin_amdgcn_exp2f(ar)), ig = __builtin_amdgcn_rcpf(1.0f + __builtin_amdgcn_exp2f(ai));
              const float a_ = __builtin_amdgcn_exp2f(k.sp * rg);
              const float xcv = __uint_as_float((unsigned)(*(const LAS unsigned short*)(XC + tt * XC_PITCH + ch * 2)) << 16);
              const float om = fmaxf(1.0f - a_ * a_, 0.f);
              av[m][j] = a_; uv[m][j] = __builtin_amdgcn_sqrtf(om) * ig * xcv; } }
    __builtin_amdgcn_sched_barrier(0);
    mid();
    __builtin_amdgcn_sched_barrier(0);
    float Pt[4], Ht[4], Pe[4], He[4], PT[4], HT[4];
#pragma unroll
    for (int m = 0; m < 4; ++m) {
        if (D == 0) {
#pragma unroll
            for (int j = 1; j < 4; ++j) { uv[m][j] = av[m][j] * uv[m][j - 1] + uv[m][j]; av[m][j] = av[m][j] * av[m][j - 1]; }
        } else {
#pragma unroll
            for (int j = 2; j >= 0; --j) { uv[m][j] = av[m][j] * uv[m][j + 1] + uv[m][j]; av[m][j] = av[m][j] * av[m][j + 1]; }
        }
        Pt[m] = D ? av[m][0] : av[m][3]; Ht[m] = D ? uv[m][0] : uv[m][3];
    }
    { const int src = (D ? lane + 16 : lane - 16) & 63; const bool ok = D ? (q <= 2) : (q >= 1); float Pp[4], Hp[4];
#pragma unroll
      for (int m = 0; m < 4; ++m) { Pp[m] = __shfl(Pt[m], src); Hp[m] = __shfl(Ht[m], src); }
#pragma unroll
      for (int m = 0; m < 4; ++m) if (ok) { Ht[m] = Pt[m] * Hp[m] + Ht[m]; Pt[m] = Pt[m] * Pp[m]; } }
    { const int src = (D ? lane + 32 : lane - 32) & 63; const bool ok = D ? (q <= 1) : (q >= 2); float Pp[4], Hp[4];
#pragma unroll
      for (int m = 0; m < 4; ++m) { Pp[m] = __shfl(Pt[m], src); Hp[m] = __shfl(Ht[m], src); }
#pragma unroll
      for (int m = 0; m < 4; ++m) if (ok) { Ht[m] = Pt[m] * Hp[m] + Ht[m]; Pt[m] = Pt[m] * Pp[m]; } }
    { const int src = (D ? lane + 16 : lane - 16) & 63; const bool first = D ? (q == 3) : (q == 0); const int tl = D ? r : 48 + r;
#pragma unroll
      for (int m = 0; m < 4; ++m) { Pe[m] = __shfl(Pt[m], src); He[m] = __shfl(Ht[m], src); PT[m] = __shfl(Pt[m], tl); HT[m] = __shfl(Ht[m], tl); }
#pragma unroll
      for (int m = 0; m < 4; ++m) if (first) { Pe[m] = 1.f; He[m] = 0.f; } }
    float cp = 1.f, chh = 0.f;
#pragma unroll
    for (int mm = 0; mm < 4; ++mm) { const int m = D ? 3 - mm : mm;
        const float Ch = Pe[m] * chh + He[m], Cp = cp * Pe[m];
#pragma unroll
        for (int j = 0; j < 4; ++j) { uv[m][j] += av[m][j] * Ch; av[m][j] *= Cp; }
        chh = PT[m] * chh + HT[m]; cp *= PT[m];
    }
    sum_p = cp; sum_h = chh;
#pragma unroll
    for (int m = 0; m < 4; ++m)
#pragma unroll
        for (int j = 0; j < 4; ++j) { const int tt = 16 * m + 4 * q + j;
            *(LAS unsigned char*)(STA + tt * A8_PITCH + ch) = (unsigned char)(unsigned)(av[m][j] * 255.f + 0.5f);
            if (D == 0) hf[m][j] = uv[m][j]; else *(LAS unsigned short*)(STS + tt * ST_PITCH + ch * 2) = (unsigned short)f2bf(hf[m][j] + uv[m][j]); }
}
__device__ __forceinline__ void phase2(const Args& a, LAS unsigned char* lds, int vcu, int G, int tid, int wave, int lane) {
    unsigned char* ws = a.ws;
    const bf16* XR = (const bf16*)(ws + WS_XR); const bf16* GW = (const bf16*)(ws + WS_GW);
    unsigned char* AF8 = (unsigned char*)a.out; unsigned char* AB8 = AF8 + (size_t)T * DM; bf16* MIX = (bf16*)(ws + WS_MIX);
    float* SUMM = (float*)(ws + WS_SUMM);
    P2Const k0, k1; int hcur = -1;
    const int NIT = BATCH * NCHUNK * 8;
    v4u pre[3];
    auto fetch = [&](int it) { const int h = it & 7, c = (it >> 3) & 63, b = it >> 9; const int t0 = c * LCH; const size_t rowb = (size_t)b * SEQ;
#pragma unroll
        for (int i = 0; i < 3; ++i) { const int q = min(tid + i * NTHREADS, 70 * 16 - 1); const int r = q >> 4, cc = q & 15; const int t = min(max(t0 - 3 + r, 0), SEQ - 1);
            pre[i] = *(const v4u*)(XR + (rowb + t) * DM + h * 128 + cc * 8); } };
    auto put = [&](int it, LAS unsigned char* dst) { const int t0 = ((it >> 3) & 63) * LCH;
#pragma unroll
        for (int i = 0; i < 3; ++i) { const int q = tid + i * NTHREADS; const int t = t0 - 3 + (q >> 4); const bool ok = t >= 0 && t < SEQ;
            const v4u w = ok ? pre[i] : (v4u){0u, 0u, 0u, 0u};
            if (q < 70 * 16) *(LAS v4u*)(dst + (q >> 4) * 256 + (q & 15) * 16) = w; } };
    bf16x8 fA0[4], fX0[4], fA1[4], fX1[4];
    auto pin0 = [&]() {
#pragma unroll
        for (int ks = 0; ks < 4; ++ks) asm volatile("" : "+v"(fA0[ks]), "+v"(fX0[ks])); };
    if (vcu < NIT) { fetch(vcu); put(vcu, lds + P2_XRT); p2_load_bfrag(fA0, fX0, GW, 0, vcu & 7, wave, lane); pin0(); }
    __syncthreads();
    int par = 0;
    for (int it = vcu; it < NIT; it += G, par ^= 1) {
        const int h = it & 7, c = (it >> 3) & 63, b = it >> 9;
        const int t0 = c * LCH; const size_t rowb = (size_t)b * SEQ;
        if (h != hcur) { p2_load_const(k0, a, 0, h, tid, wave, lane); p2_load_const(k1, a, 1, h, tid, wave, lane); hcur = h;
#pragma unroll
            for (int t = 0; t < 4; ++t) asm volatile("" : "+v"(k0.w0[t]), "+v"(k0.w1[t]), "+v"(k1.w0[t]), "+v"(k1.w1[t]));
            asm volatile("" : "+v"(k0.b0), "+v"(k0.b1), "+v"(k1.b0), "+v"(k1.b1));
            asm volatile("" : "+v"(k0.bav), "+v"(k0.bxv), "+v"(k0.sp), "+v"(k1.bav), "+v"(k1.bxv), "+v"(k1.sp)); }
        const LAS unsigned char* XRT = lds + (par ? P2_XRT2 : P2_XRT); LAS unsigned char* XRTn = lds + (par ? P2_XRT : P2_XRT2);
        const bool has_next = it + G < NIT; const int itn = has_next ? it + G : it;
        p2_conv<0>(k0, lds, XRT, tid); p2_conv<1>(k1, lds, XRT, tid);
        __syncthreads();
        float hf[4][4], sp0, sh0, sp1, sh1;
        p2_dir<0>(k0, lds, hf, fA0, fX0, [&]() { p2_load_bfrag(fA1, fX1, GW, 1, h, wave, lane); fetch(itn); }, sp0, sh0, wave, lane);
        p2_dir<1>(k1, lds, hf, fA1, fX1, [&]() { p2_load_bfrag(fA0, fX0, GW, 0, itn & 7, wave, lane); }, sp1, sh1, wave, lane);
        pin0();
        if (has_next) put(itn, XRTn);
        if ((lane >> 4) == 0) { float* sm = SUMM + ((size_t)((b * NCHUNK + c) * 2) * 2) * DM + h * 128 + 16 * wave + (lane & 15); sm[0] = sp0; sm[DM] = sh0; sm[2 * DM] = sp1; sm[3 * DM] = sh1; }
        __syncthreads();
        { const int rr = tid >> 3, cc = tid & 7; const size_t grow = rowb + t0 + rr;
          const v4u wa_ = *(const LAS v4u*)(lds + P2_STA + rr * A8_PITCH + cc * 16), wb_ = *(const LAS v4u*)(lds + P2_STA + A8_TILE + rr * A8_PITCH + cc * 16);
          *(v4u*)(AF8 + grow * DM + h * 128 + cc * 16) = wa_; *(v4u*)(AB8 + grow * DM + h * 128 + cc * 16) = wb_; }
#pragma unroll
        for (int i = 0; i < 2; ++i) { const int e = tid + i * NTHREADS; const int rr = e >> 4, cc = e & 15; const size_t grow = rowb + t0 + rr;
            const v4u ws_ = *(const LAS v4u*)(lds + P2_STS + rr * ST_PITCH + cc * 16);
            *(v4u*)(MIX + grow * D_MIX + h * 128 + cc * 8) = ws_; }
    }
}
__device__ __forceinline__ void phase2b(const Args& a, int vcu, int G, int tid) {
    const float* SUMM = (const float*)(a.ws + WS_SUMM); float* CARRY = (float*)(a.ws + WS_CARRY);
    for (int i = vcu * NTHREADS + tid; i < BATCH * 2 * DM; i += G * NTHREADS) {
        const int ch = i & 1023, d = (i >> 10) & 1, b = i >> 11;
        float pa[NCHUNK], ph[NCHUNK];
#pragma unroll
        for (int k = 0; k < NCHUNK; ++k) { const float* sm = SUMM + ((size_t)((b * NCHUNK + k) * 2 + d) * 2) * DM + ch; pa[k] = sm[0]; ph[k] = sm[DM]; }
        float cv = 0.f;
        if (d == 0) {
#pragma unroll
            for (int k = 0; k < NCHUNK; ++k) { CARRY[(size_t)((b * NCHUNK + k) * 2 + d) * DM + ch] = cv; cv = pa[k] * cv + ph[k]; }
        } else {
#pragma unroll
            for (int k = NCHUNK - 1; k >= 0; --k) { CARRY[(size_t)((b * NCHUNK + k) * 2 + d) * DM + ch] = cv; cv = pa[k] * cv + ph[k]; }
        }
    }
}
struct P4Tok { v4u s[2], g[2], cbv, pc; v2u f[2], bk[2]; };
#define UB8(w, k) ((float)(((w) >> (8 * (k))) & 0xffu))
__device__ __forceinline__ float gelu_tanh_fast(float x) { const float u2 = 1.5957691216057308f * (x + 0.044715f * x * x * x); return x * __builtin_amdgcn_rcpf(1.0f + __builtin_amdgcn_exp2f(-1.4426950408889634f * u2)); }
__device__ __forceinline__ void p4_load(P4Tok& t, const bf16* MIX, const unsigned char* AFp, const unsigned char* ABp, const bf16* GATE, const bf16* CCX, size_t row, bool next_valid, int lane) {
#pragma unroll
    for (int hf = 0; hf < 2; ++hf) { const int ch = hf * 512 + 8 * lane;
        t.s[hf] = *(const v4u*)(MIX + row * D_MIX + ch); t.f[hf] = *(const v2u*)(AFp + row * DM + ch); t.bk[hf] = *(const v2u*)(ABp + row * DM + ch); t.g[hf] = *(const v4u*)(GATE + row * DM + ch); }
    t.cbv = *(const v4u*)(MIX + row * D_MIX + 1024 + 8 * lane);
    t.pc = next_valid ? *(const v4u*)(CCX + (row + 1) * 512 + 8 * lane) : (v4u){0u, 0u, 0u, 0u};
}
__device__ __forceinline__ void phase3(const Args& a, int vcu, int G, int wave, int lane, bool do_store) {
    unsigned char* ws = a.ws;
    bf16* MIX = (bf16*)(ws + WS_MIX); const unsigned char* AFp = (const unsigned char*)a.out; const unsigned char* ABp = AFp + (size_t)T * DM;
    const bf16* GATE = (const bf16*)(ws + WS_GATE); const bf16* CCX = (const bf16*)(ws + WS_CCX); const float* CARRY = (const float*)(ws + WS_CARRY);
    const float* cw = a.in[11]; const float* gnl = a.in[12]; const float* gnc = a.in[13];
    const __amdgpu_buffer_rsrc_t mixrs = __builtin_amdgcn_make_buffer_rsrc((void*)MIX, 0, (int)((size_t)T * D_MIX * 2), 0x00020000);
    float gn[16], w3[3][8], gc[8];
#pragma unroll
    for (int hf = 0; hf < 2; ++hf)
#pragma unroll
        for (int q = 0; q < 2; ++q) { const int ch = hf * 512 + 8 * lane + 4 * q; const f32x4 g = *(const f32x4*)(gnl + ch);
#pragma unroll
            for (int i = 0; i < 4; ++i) gn[hf * 8 + q * 4 + i] = g[i]; }
#pragma unroll
    for (int q = 0; q < 2; ++q) { const int ch = 8 * lane + 4 * q; const f32x4 g = *(const f32x4*)(gnc + ch);
#pragma unroll
        for (int k = 0; k < 3; ++k) { const f32x4 w = *(const f32x4*)(cw + k * 512 + ch);
#pragma unroll
            for (int i = 0; i < 4; ++i) w3[k][q * 4 + i] = w[i]; }
#pragma unroll
        for (int i = 0; i < 4; ++i) gc[q * 4 + i] = g[i]; }
    for (int item = vcu; item < BATCH * NCHUNK; item += G) {
        const int b = item >> 6, c = item & 63; const size_t row0 = (size_t)b * SEQ + c * LCH + 8 * wave; const int tpos0 = c * LCH + 8 * wave;
        float cf[16], cb[16];
#pragma unroll
        for (int hf = 0; hf < 2; ++hf)
#pragma unroll
            for (int q = 0; q < 2; ++q) { const int ch = hf * 512 + 8 * lane + 4 * q;
                const f32x4 f = *(const f32x4*)(CARRY + (size_t)((b * NCHUNK + c) * 2 + 0) * DM + ch), bk = *(const f32x4*)(CARRY + (size_t)((b * NCHUNK + c) * 2 + 1) * DM + ch);
#pragma unroll
                for (int i = 0; i < 4; ++i) { cf[hf * 8 + q * 4 + i] = f[i] * (1.f / 255.f); cb[hf * 8 + q * 4 + i] = bk[i] * (1.f / 255.f); } }
        float pm[8], p0[8], pp[8];
        { v4u c0 = (v4u){0u, 0u, 0u, 0u};
          if (tpos0 > 0) c0 = *(const v4u*)(CCX + (row0 - 1) * 512 + 8 * lane);
          const v4u c1 = *(const v4u*)(CCX + row0 * 512 + 8 * lane);
#pragma unroll
          for (int i = 0; i < 4; ++i) { pm[2 * i] = bflo(c0[i]); pm[2 * i + 1] = bfhi(c0[i]); p0[2 * i] = bflo(c1[i]); p0[2 * i + 1] = bfhi(c1[i]); } }
        P4Tok cur, nxt;
        p4_load(cur, MIX, AFp, ABp, GATE, CCX, row0, tpos0 + 1 < SEQ, lane);
#pragma unroll
        for (int i = 0; i < 8; ++i) {
            const size_t row = row0 + i;
            if (i + 1 < 8) p4_load(nxt, MIX, AFp, ABp, GATE, CCX, row + 1, tpos0 + i + 2 < SEQ, lane);
            float y[16]; float ss = 0.f;
#pragma unroll
            for (int hf = 0; hf < 2; ++hf)
#pragma unroll
                for (int e2 = 0; e2 < 4; ++e2) { const int e = hf * 8 + 2 * e2;
                    const unsigned fw = cur.f[hf][e2 >> 1], bw = cur.bk[hf][e2 >> 1];
                    const float l0 = bflo(cur.s[hf][e2]) + UB8(fw, (2 * e2) & 3) * cf[e] + UB8(bw, (2 * e2) & 3) * cb[e], l1 = bfhi(cur.s[hf][e2]) + UB8(fw, (2 * e2 + 1) & 3) * cf[e + 1] + UB8(bw, (2 * e2 + 1) & 3) * cb[e + 1];
                    y[e] = gelu_tanh_fast(bflo(cur.g[hf][e2])) * l0; y[e + 1] = gelu_tanh_fast(bfhi(cur.g[hf][e2])) * l1; ss += y[e] * y[e] + y[e + 1] * y[e + 1]; }
#pragma unroll
            for (int e2 = 0; e2 < 4; ++e2) { pp[2 * e2] = bflo(cur.pc[e2]); pp[2 * e2 + 1] = bfhi(cur.pc[e2]); }
            float yc[8]; float ssc = 0.f;
#pragma unroll
            for (int e2 = 0; e2 < 4; ++e2) { const float a0 = w3[0][2 * e2] * pm[2 * e2] + w3[1][2 * e2] * p0[2 * e2] + w3[2][2 * e2] * pp[2 * e2], a1 = w3[0][2 * e2 + 1] * pm[2 * e2 + 1] + w3[1][2 * e2 + 1] * p0[2 * e2 + 1] + w3[2][2 * e2 + 1] * pp[2 * e2 + 1];
                yc[2 * e2] = a0 * bflo(cur.cbv[e2]); yc[2 * e2 + 1] = a1 * bfhi(cur.cbv[e2]); ssc += yc[2 * e2] * yc[2 * e2] + yc[2 * e2 + 1] * yc[2 * e2 + 1]; }
#pragma unroll
            for (int o = 1; o < 64; o <<= 1) { ss += __shfl_xor(ss, o); ssc += __shfl_xor(ssc, o); }
            const float r = __builtin_amdgcn_rsqf(ss * (1.f / 1024.f) + RMS_EPS), r2 = __builtin_amdgcn_rsqf(ssc * (1.f / 512.f) + RMS_EPS);
#pragma unroll
            for (int hf = 0; hf < 2; ++hf) { v4u o;
#pragma unroll
                for (int e2 = 0; e2 < 4; ++e2) { const int e = hf * 8 + 2 * e2; o[e2] = pk2(y[e] * r * gn[e], y[e + 1] * r * gn[e + 1]); }
                if (do_store) ST16_WTB(mixrs, (int)((row * D_MIX + hf * 512 + 8 * lane) * 2), o); else asm volatile("" :: "v"(o)); }
            { v4u oc;
#pragma unroll
              for (int e2 = 0; e2 < 4; ++e2) oc[e2] = pk2(yc[2 * e2] * r2 * gc[2 * e2], yc[2 * e2 + 1] * r2 * gc[2 * e2 + 1]);
              if (do_store) ST16_WTB(mixrs, (int)((row * D_MIX + 1024 + 8 * lane) * 2), oc); else asm volatile("" :: "v"(oc)); }
#pragma unroll
            for (int e = 0; e < 8; ++e) { pm[e] = p0[e]; p0[e] = pp[e]; }
            if (i + 1 < 8) cur = nxt;
        }
    }
}
__device__ __forceinline__ void phase5(const Args& a, int vcu, int G, int tid, int wave, int lane) {
    unsigned char* ws = a.ws;
    const int gw = vcu * NWAVES + wave, NGW = G * NWAVES;
#if LN1_PIPE
    ln_rows_bf16((const bf16*)(ws + WS_PRE1), a.in[15], a.in[16], (bf16*)(ws + WS_H1), gw, NGW, lane);
#else
    for (int m = gw; m < T; m += NGW) ln_row_bf16_b((const bf16*)(ws + WS_PRE1) + (size_t)m * DM, a.in[15], a.in[16], (bf16*)(ws + WS_H1) + (size_t)m * DM, lane);
#endif
#if !TABLE_FP4
    const size_t NV = (size_t)16384 * 1024 / 16;
    for (size_t i = (size_t)vcu * NTHREADS + tid; i < 2 * NV; i += (size_t)G * NTHREADS) {
        const bool second = i >= NV; const size_t j = second ? i - NV : i;
        const float* src = (second ? a.in[21] : a.in[20]) + j * 16;
        const float sc = second ? V_SCALE : U_SCALE;
        unsigned char* dst = ws + (second ? WS_V8 : WS_U8) + j * 16;
        v4u o;
#pragma unroll
        for (int q = 0; q < 4; ++q) { f32x4 v = *(const f32x4*)(src + 4 * q) * sc;
#pragma unroll
            for (int e = 0; e < 4; ++e) v[e] = fminf(fmaxf(v[e], -224.f), 224.f);
            int w = 0; w = __builtin_amdgcn_cvt_pk_fp8_f32(v[0], v[1], w, false); w = __builtin_amdgcn_cvt_pk_fp8_f32(v[2], v[3], w, true); o[q] = (unsigned)w; }
        *(v4u*)dst = o;
    }
#endif
}
#define INS16(v, x) do { _Pragma("unroll") for (int j_ = 15; j_ >= 1; --j_) v[j_] = __builtin_amdgcn_fmed3f(v[j_ - 1], v[j_], (x)); v[0] = fmaxf(v[0], (x)); } while (0)
typedef float f32x16 __attribute__((ext_vector_type(16)));
constexpr int KP = 272;
#define CE_(v, a, b) do { const float hi_ = fmaxf(v[a], v[b]), lo_ = fminf(v[a], v[b]); v[a] = hi_; v[b] = lo_; } while (0)
__device__ __forceinline__ void sort16_desc(float (&t)[16]) {
    CE_(t,0,13); CE_(t,1,12); CE_(t,2,15); CE_(t,3,14); CE_(t,4,8); CE_(t,5,6); CE_(t,7,11); CE_(t,9,10);
    CE_(t,0,5); CE_(t,1,7); CE_(t,2,9); CE_(t,3,4); CE_(t,6,13); CE_(t,8,14); CE_(t,10,15); CE_(t,11,12);
    CE_(t,0,1); CE_(t,2,3); CE_(t,4,5); CE_(t,6,8); CE_(t,7,9); CE_(t,10,11); CE_(t,12,13); CE_(t,14,15);
    CE_(t,0,2); CE_(t,1,3); CE_(t,4,10); CE_(t,5,11); CE_(t,6,7); CE_(t,8,9); CE_(t,12,14); CE_(t,13,15);
    CE_(t,1,2); CE_(t,3,12); CE_(t,4,6); CE_(t,5,7); CE_(t,8,10); CE_(t,9,11); CE_(t,13,14);
    CE_(t,1,4); CE_(t,2,6); CE_(t,5,8); CE_(t,7,10); CE_(t,9,13); CE_(t,11,14);
    CE_(t,2,4); CE_(t,3,6); CE_(t,9,12); CE_(t,11,13);
    CE_(t,3,5); CE_(t,6,8); CE_(t,7,9); CE_(t,10,12);
    CE_(t,3,4); CE_(t,5,6); CE_(t,7,8); CE_(t,9,10); CE_(t,11,12);
    CE_(t,6,7); CE_(t,8,9);
}
__device__ __forceinline__ void merge16_desc(float (&v)[16], const float (&t)[16]) {
#pragma unroll
    for (int j = 0; j < 16; ++j) v[j] = fmaxf(v[j], t[15 - j]);
#pragma unroll
    for (int d = 8; d >= 1; d >>= 1)
#pragma unroll
        for (int i = 0; i < 16; ++i) if ((i & d) == 0) CE_(v, i, i + d);
}
__device__ __forceinline__ void topk_list(const LAS unsigned char* Kl, const bf16* Qrow, int lane, float (&v)[16]) {
    const int r = lane & 31, hh = lane >> 5;
    bf16x8 qf[8];
#pragma unroll
    for (int ks = 0; ks < 8; ++ks) qf[ks] = *(const bf16x8*)(Qrow + ks * 16 + 8 * hh);
#pragma unroll
    for (int j = 0; j < 16; ++j) v[j] = -3.0e38f;
#pragma unroll 1
    for (int m = 0; m < 4; ++m) {
        f32x16 acc;
#pragma unroll
        for (int i = 0; i < 16; ++i) acc[i] = 0.f;
#pragma unroll
        for (int ks = 0; ks < 8; ++ks) { const bf16x8 kf = *(const LAS bf16x8*)(Kl + (32 * m + r) * KP + (ks * 16 + 8 * hh) * 2);
            acc = __builtin_amdgcn_mfma_f32_32x32x16_bf16(kf, qf[ks], acc, 0, 0, 0); }
        float t16[16];
#pragma unroll
        for (int i = 0; i < 16; ++i) { const unsigned kid = (unsigned)(32 * m + (i & 3) + 8 * (i >> 2) + 4 * hh);
            const float sc_ = acc[i]; t16[i] = __uint_as_float((__float_as_uint(sc_) & ~0x7Fu) | kid); }
        sort16_desc(t16); merge16_desc(v, t16);
    }
    float o[16];
#pragma unroll
    for (int j = 0; j < 16; ++j) o[j] = __shfl_xor(v[j], 32);
    merge16_desc(v, o);
}
__device__ __forceinline__ void phase7(const Args& a, LAS unsigned char* lds, int vcu, int G, int tid, int wave, int lane) {
    unsigned char* ws = a.ws;
    const bf16* Q = (const bf16*)(ws + WS_Q);
    int* IDX = (int*)(ws + WS_IDX); float* Gp = (float*)(ws + WS_G);
    for (int q = tid; q < 2 * 128 * 16; q += NTHREADS) { const int which = q >> 11, row = (q >> 4) & 127, ch = q & 15;
        const v4u kv = *(const v4u*)((const bf16*)(ws + (which ? WS_K2 : WS_K1)) + row * 128 + ch * 8);
        *(LAS v4u*)(lds + which * 128 * KP + row * KP + ch * 16) = kv; }
    __syncthreads();
    const int gw = vcu * NWAVES + wave, NGW = G * NWAVES;
    for (int item = gw; item < (T / 32) * 8; item += NGW) {
        const int h = item & 7, tg = item >> 3; const size_t row = (size_t)tg * 32 + (lane & 31);
        const bf16* Qrow = Q + row * D_Q + h * 256;
#if TABLE_FP4
        TabGroup tgr[4]; const size_t tg0 = (size_t)item * 256 + lane;
#pragma unroll
        for (int gi = 0; gi < 4; ++gi) if (tg0 + 64 * gi < 2 * TAB_GROUPS) tab_load(tgr[gi], a, tg0 + 64 * gi);
#endif
        float va[16], vb[16];
        topk_list(lds, Qrow, lane, va);
        topk_list(lds + 128 * KP, Qrow + 128, lane, vb);
        float cnd[16]; float sa[16], sb[16];
#pragma unroll
        for (int j = 0; j < 16; ++j) { sa[j] = __builtin_bit_cast(float, __builtin_bit_cast(unsigned, va[j]) & ~0x7Fu); sb[j] = __builtin_bit_cast(float, __builtin_bit_cast(unsigned, vb[j]) & ~0x7Fu); cnd[j] = -3.0e38f; }
        { float kc[50]; int cnt = 0;
#pragma unroll
          for (int i = 0; i < 16; ++i)
#pragma unroll
              for (int j = 0; j < 16; ++j) if ((i + 1) * (j + 1) <= 16) { kc[cnt] = __builtin_bit_cast(float, (__builtin_bit_cast(unsigned, sa[i] + sb[j]) & ~0xFFu) | (unsigned)(i * 16 + j)); ++cnt; }
          const bool odd = (lane >> 5) != 0;
#pragma unroll
          for (int p = 0; p < 25; ++p) { const float key = odd ? kc[2 * p + 1] : kc[2 * p]; INS16(cnd, key); }
          float oc[16];
#pragma unroll
          for (int j = 0; j < 16; ++j) oc[j] = __shfl_xor(cnd[j], 32);
          merge16_desc(cnd, oc); }
        LAS unsigned char* tb = lds + 2 * 128 * KP + wave * 2048 + lane * 32;
#pragma unroll
        for (int j = 0; j < 16; ++j) { tb[j] = (unsigned char)__builtin_bit_cast(unsigned, va[j]); tb[16 + j] = (unsigned char)__builtin_bit_cast(unsigned, vb[j]); }
        const float mx = __builtin_bit_cast(float, __builtin_bit_cast(unsigned, cnd[0]) & ~0xFFu);
        const int hh8 = lane >> 5;
        float e[8]; float sum = 0.f; unsigned ids[8];
#pragma unroll
        for (int k = 0; k < 8; ++k) { float hv_ = cnd[8 + k]; asm volatile("" : "+v"(hv_));
            const unsigned bits = __builtin_bit_cast(unsigned, hh8 ? hv_ : cnd[k]); const unsigned pi = (bits >> 4) & 15u, pj = bits & 15u;
            e[k] = __expf(__builtin_bit_cast(float, bits & ~0xFFu) - mx); sum += e[k];
            const unsigned i1 = (unsigned)tb[pi] & 0x7Fu, i2 = (unsigned)tb[16 + pj] & 0x7Fu;
            ids[k] = i1 * 128u + i2; }
        sum += __shfl_xor(sum, 32);
        const float inv = 1.0f / sum; const size_t o = row * 128 + h * 16 + 8 * hh8;
#pragma unroll
        for (int k = 0; k < 8; k += 4) { *(v4u*)(IDX + o + k) = (v4u){ids[k], ids[k + 1], ids[k + 2], ids[k + 3]};
            *(f32x4*)(Gp + o + k) = (f32x4){e[k] * inv, e[k + 1] * inv, e[k + 2] * inv, e[k + 3] * inv}; }
#if TABLE_FP4
#pragma unroll
        for (int gi = 0; gi < 4; ++gi) if (tg0 + 64 * gi < 2 * TAB_GROUPS) tab_store(tgr[gi], a, tg0 + 64 * gi);
#endif
    }
#if TABLE_FP4
    for (size_t i2 = (size_t)(T / 32) * 8 * 256 + (size_t)gw * 64 + lane; i2 < 2 * TAB_GROUPS; i2 += (size_t)NGW * 64) { TabGroup tg1; tab_load(tg1, a, i2); tab_store(tg1, a, i2); }
#endif
    __syncthreads();
}
#if TABLE_FP4
typedef float f32x2 __attribute__((ext_vector_type(2)));
typedef _Float16 h16x2 __attribute__((ext_vector_type(2)));
typedef unsigned v2u_ __attribute__((ext_vector_type(2)));
#define P8_LOADB(buf, RSRC, b0) do { _Pragma("unroll") for (int k_ = 0; k_ < 16; ++k_) { const int ie_ = __builtin_amdgcn_readlane(idr, (b0) + k_); \
    buf[k_] = __builtin_bit_cast(v2u, __builtin_amdgcn_raw_buffer_load_b64((RSRC), voff, ie_ * ROWB, 0)); } } while (0)
__device__ __forceinline__ void phase8a(const Args& a, int vcu, int G, int wave, int lane) {
    unsigned char* ws = a.ws;
    const bf16* H1 = (const bf16*)(ws + WS_H1); const unsigned char* U8 = ws + WS_U8;
    const int* IDX = (const int*)(ws + WS_IDX); float* DOT = (float*)(ws + WS_DOT);
    const __amdgpu_buffer_rsrc_t urs = __builtin_amdgcn_make_buffer_rsrc((void*)U8, 0, 16384 * ROWB, 0x00020000); const int voff = 8 * lane;
    const int gw = vcu * NWAVES + wave, NGW = G * NWAVES;
    for (int t = gw; t < T; t += NGW) {
        const v4u xa = *(const v4u*)(H1 + (size_t)t * DM + 16 * lane), xb = *(const v4u*)(H1 + (size_t)t * DM + 16 * lane + 8);
        float xf[16];
#pragma unroll
        for (int i = 0; i < 4; ++i) { xf[2 * i] = bflo(xa[i]); xf[2 * i + 1] = bfhi(xa[i]); xf[8 + 2 * i] = bflo(xb[i]); xf[8 + 2 * i + 1] = bfhi(xb[i]); }
        float amax = 1e-20f;
#pragma unroll
        for (int i = 0; i < 16; ++i) amax = fmaxf(amax, fabsf(xf[i]));
#pragma unroll
        for (int o = 1; o < 64; o <<= 1) amax = fmaxf(amax, __shfl_xor(amax, o));
        const float sx = 119.0f / amax;
        unsigned xh[2] = {0u, 0u}, xl[2] = {0u, 0u}; int sxi = 0;
#pragma unroll
        for (int i = 0; i < 16; ++i) { const int xi = (int)rintf(xf[i] * sx); const int lo = ((xi + 8) & 15) - 8, hi = (xi - lo) >> 4; sxi += xi;
            xh[i >> 3] |= ((unsigned)hi & 15u) << (4 * (i & 7)); xl[i >> 3] |= ((unsigned)lo & 15u) << (4 * (i & 7)); }
#pragma unroll
        for (int o = 1; o < 64; o <<= 1) sxi += __shfl_xor(sxi, o);
        const float dscale = U_STEP / sx;
#pragma unroll 1
        for (int part = 0; part < 2; ++part) {
            const int idr = IDX[(size_t)t * 128 + part * 64 + lane];
            int p[64]; v2u ub[2][16];
            P8_LOADB(ub[0], urs, 0);
#pragma unroll
            for (int bb = 0; bb < 4; ++bb) {
                if (bb + 1 < 4) P8_LOADB(ub[(bb + 1) & 1], urs, 16 * (bb + 1));
                __builtin_amdgcn_sched_barrier(0);
#pragma unroll
                for (int k = 0; k < 16; ++k) { const v2u uw = ub[bb & 1][k];
                    int ah = __builtin_amdgcn_sdot8((int)uw[0], (int)xh[0], 0, false); ah = __builtin_amdgcn_sdot8((int)uw[1], (int)xh[1], ah, false);
                    int al = __builtin_amdgcn_sdot8((int)uw[0], (int)xl[0], 0, false); al = __builtin_amdgcn_sdot8((int)uw[1], (int)xl[1], al, false);
                    p[16 * bb + k] = 16 * ah + al; }
                __builtin_amdgcn_sched_barrier(0);
            }
#pragma unroll
            for (int i = 0; i < 32; ++i) { const auto r_ = __builtin_amdgcn_permlane32_swap((unsigned)p[i], (unsigned)p[i + 32], false, false); p[i] = (int)r_[0] + (int)r_[1]; }
#pragma unroll
            for (int i = 0; i < 16; ++i) { const auto r_ = __builtin_amdgcn_permlane16_swap((unsigned)p[i], (unsigned)p[i + 16], false, false); p[i] = (int)r_[0] + (int)r_[1]; }
#pragma unroll
            for (int sft = 8; sft >= 1; sft >>= 1) { const bool up = (lane & sft) != 0;
#pragma unroll
                for (int i = 0; i < sft; ++i) { const int send = up ? p[i] : p[i + sft], keep = up ? p[i + sft] : p[i]; p[i] = keep + __shfl_xor(send, sft); } }
            DOT[(size_t)t * 128 + part * 64 + lane] = dscale * ((float)p[0] + 0.5f * (float)sxi);
        }
    }
}
__device__ __forceinline__ void phase8b(const Args& a, int vcu, int G, int wave, int lane) {
    unsigned char* ws = a.ws;
    const bf16* H1 = (const bf16*)(ws + WS_H1); const unsigned char* V8 = ws + WS_V8;
    const int* IDX = (const int*)(ws + WS_IDX); const float* Gp = (const float*)(ws + WS_G); const float* DOT = (const float*)(ws + WS_DOT);
    const float* g2 = a.in[22]; const float* b2 = a.in[23];
    const __amdgpu_buffer_rsrc_t vrs = __builtin_amdgcn_make_buffer_rsrc((void*)V8, 0, 16384 * ROWB, 0x00020000); const int voff = 8 * lane;
    const int gw = vcu * NWAVES + wave, NGW = G * NWAVES;
    for (int t = gw; t < T; t += NGW) {
        h16x2 y16[8];
#pragma unroll
        for (int i = 0; i < 8; ++i) y16[i] = (h16x2){(_Float16)0.f, (_Float16)0.f};
#pragma unroll 1
        for (int part = 0; part < 2; ++part) {
            const int idr = IDX[(size_t)t * 128 + part * 64 + lane]; const float gr = Gp[(size_t)t * 128 + part * 64 + lane], dot = DOT[(size_t)t * 128 + part * 64 + lane];
            v2u vb[2][16];
            P8_LOADB(vb[0], vrs, 0);
            const float wv = gr * gelu_erf(dot) * (1.0f / V_SCALE);
            const h16x2 wh = (h16x2){(_Float16)wv, (_Float16)wv}; const int wbits = __builtin_bit_cast(int, wh);
#pragma unroll
            for (int bb = 0; bb < 4; ++bb) {
                if (bb + 1 < 4) P8_LOADB(vb[(bb + 1) & 1], vrs, 16 * (bb + 1));
                __builtin_amdgcn_sched_barrier(0);
#pragma unroll
                for (int k = 0; k < 16; ++k) { const h16x2 we = __builtin_bit_cast(h16x2, __builtin_amdgcn_readlane(wbits, 16 * bb + k)); const v2u vw = vb[bb & 1][k];
#pragma unroll
                    for (int q = 0; q < 2; ++q) { const unsigned wq = vw[q];
                        y16[4 * q] = __builtin_elementwise_fma(__builtin_bit_cast(h16x2, __builtin_amdgcn_cvt_scalef32_pk_f16_fp4(wq, 1.0f, 0)), we, y16[4 * q]);
                        y16[4 * q + 1] = __builtin_elementwise_fma(__builtin_bit_cast(h16x2, __builtin_amdgcn_cvt_scalef32_pk_f16_fp4(wq, 1.0f, 1)), we, y16[4 * q + 1]);
                        y16[4 * q + 2] = __builtin_elementwise_fma(__builtin_bit_cast(h16x2, __builtin_amdgcn_cvt_scalef32_pk_f16_fp4(wq, 1.0f, 2)), we, y16[4 * q + 2]);
                        y16[4 * q + 3] = __builtin_elementwise_fma(__builtin_bit_cast(h16x2, __builtin_amdgcn_cvt_scalef32_pk_f16_fp4(wq, 1.0f, 3)), we, y16[4 * q + 3]); } }
                __builtin_amdgcn_sched_barrier(0);
            }
        }
        const v4u xa = *(const v4u*)(H1 + (size_t)t * DM + 16 * lane), xb = *(const v4u*)(H1 + (size_t)t * DM + 16 * lane + 8);
        float y[16]; float s = 0.f;
#pragma unroll
        for (int i = 0; i < 4; ++i) { y[2 * i] = (float)y16[i].x + ALPHA * bflo(xa[i]); y[2 * i + 1] = (float)y16[i].y + ALPHA * bfhi(xa[i]); y[8 + 2 * i] = (float)y16[4 + i].x + ALPHA * bflo(xb[i]); y[8 + 2 * i + 1] = (float)y16[4 + i].y + ALPHA * bfhi(xb[i]); }
#pragma unroll
        for (int i = 0; i < 16; ++i) s += y[i];
        const float mean = wave_sum(s) * (1.f / DM); float s2 = 0.f;
#pragma unroll
        for (int i = 0; i < 16; ++i) { y[i] -= mean; s2 += y[i] * y[i]; }
        const float rstd = __builtin_amdgcn_rsqf(wave_sum(s2) * (1.f / DM) + LN_EPS);
#pragma unroll
        for (int q = 0; q < 4; ++q) { const int col = 16 * lane + 4 * q; const f32x4 gv = *(const f32x4*)(g2 + col), bv = *(const f32x4*)(b2 + col);
            f32x4 o; o[0] = y[4 * q] * rstd * gv[0] + bv[0]; o[1] = y[4 * q + 1] * rstd * gv[1] + bv[1]; o[2] = y[4 * q + 2] * rstd * gv[2] + bv[2]; o[3] = y[4 * q + 3] * rstd * gv[3] + bv[3];
            *(f32x4*)(a.out + (size_t)t * DM + col) = o; }
    }
}
#undef P8_LOADB
#else
typedef float f32x2 __attribute__((ext_vector_type(2)));
__device__ __forceinline__ void phase8(const Args& a, int vcu, int G, int wave, int lane) {
    unsigned char* ws = a.ws;
    const bf16* H1 = (const bf16*)(ws + WS_H1); const unsigned char* U8 = ws + WS_U8; const unsigned char* V8 = ws + WS_V8;
    const int* IDX = (const int*)(ws + WS_IDX); const float* Gp = (const float*)(ws + WS_G);
    const float* g2 = a.in[22]; const float* b2 = a.in[23];
    const int gw = vcu * NWAVES + wave, NGW = G * NWAVES;
    for (int t = gw; t < T; t += NGW) {
        const v4u xa = *(const v4u*)(H1 + (size_t)t * DM + 16 * lane), xb = *(const v4u*)(H1 + (size_t)t * DM + 16 * lane + 8);
        f32x2 x2[8], y2[8];
#pragma unroll
        for (int i = 0; i < 4; ++i) { x2[i] = (f32x2){bflo(xa[i]), bfhi(xa[i])}; x2[4 + i] = (f32x2){bflo(xb[i]), bfhi(xb[i])}; }
#pragma unroll
        for (int i = 0; i < 8; ++i) y2[i] = (f32x2){0.f, 0.f};
#pragma unroll 1
        for (int part = 0; part < 2; ++part) {
            const int idr = IDX[(size_t)t * 128 + part * 64 + lane]; const float gr = Gp[(size_t)t * 128 + part * 64 + lane];
            float p[64];
#pragma unroll
            for (int e = 0; e < 64; ++e) {
                const int ie = __builtin_amdgcn_readlane(idr, e);
                f32x2 acc = (f32x2){0.f, 0.f};
#if TABLE_FP4
                const v2u uw = *(const v2u*)(U8 + (size_t)ie * ROWB + 8 * lane);
#pragma unroll
                for (int q = 0; q < 2; ++q) { const unsigned wq = uw[q];
                    acc += __builtin_amdgcn_cvt_scalef32_pk_f32_fp4(wq, 1.0f, 0) * x2[4 * q]; acc += __builtin_amdgcn_cvt_scalef32_pk_f32_fp4(wq, 1.0f, 1) * x2[4 * q + 1];
                    acc += __builtin_amdgcn_cvt_scalef32_pk_f32_fp4(wq, 1.0f, 2) * x2[4 * q + 2]; acc += __builtin_amdgcn_cvt_scalef32_pk_f32_fp4(wq, 1.0f, 3) * x2[4 * q + 3]; }
#else
                const v4u uw = *(const v4u*)(U8 + (size_t)ie * ROWB + 16 * lane);
#pragma unroll
                for (int q = 0; q < 4; ++q) { const f32x2 lo = __builtin_amdgcn_cvt_pk_f32_fp8((int)uw[q], false), hi = __builtin_amdgcn_cvt_pk_f32_fp8((int)uw[q], true);
                    acc += lo * x2[2 * q]; acc += hi * x2[2 * q + 1]; }
#endif
                p[e] = acc.x + acc.y;
            }
#pragma unroll
            for (int sft = 32; sft >= 1; sft >>= 1) { const bool up = (lane & sft) != 0;
#pragma unroll
                for (int i = 0; i < sft; ++i) { const float send = up ? p[i] : p[i + sft], keep = up ? p[i + sft] : p[i]; p[i] = keep + __shfl_xor(send, sft); } }
            const float wv = gr * gelu_erf(p[0] * (1.0f / U_SCALE)) * (1.0f / V_SCALE);
#pragma unroll
            for (int e = 0; e < 64; ++e) {
                const int ie = __builtin_amdgcn_readlane(idr, e); const float we = __builtin_bit_cast(float, __builtin_amdgcn_readlane(__builtin_bit_cast(int, wv), e));
#if TABLE_FP4
                const v2u vw = *(const v2u*)(V8 + (size_t)ie * ROWB + 8 * lane);
#pragma unroll
                for (int q = 0; q < 2; ++q) { const unsigned wq = vw[q];
                    y2[4 * q] += __builtin_amdgcn_cvt_scalef32_pk_f32_fp4(wq, 1.0f, 0) * we; y2[4 * q + 1] += __builtin_amdgcn_cvt_scalef32_pk_f32_fp4(wq, 1.0f, 1) * we;
                    y2[4 * q + 2] += __builtin_amdgcn_cvt_scalef32_pk_f32_fp4(wq, 1.0f, 2) * we; y2[4 * q + 3] += __builtin_amdgcn_cvt_scalef32_pk_f32_fp4(wq, 1.0f, 3) * we; }
#else
                const v4u vw = *(const v4u*)(V8 + (size_t)ie * ROWB + 16 * lane);
#pragma unroll
                for (int q = 0; q < 4; ++q) { const f32x2 lo = __builtin_amdgcn_cvt_pk_f32_fp8((int)vw[q], false), hi = __builtin_amdgcn_cvt_pk_f32_fp8((int)vw[q], true);
                    y2[2 * q] += lo * we; y2[2 * q + 1] += hi * we; }
#endif
            }
        }
        float s = 0.f;
#pragma unroll
        for (int i = 0; i < 8; ++i) { y2[i] += x2[i] * ALPHA; s += y2[i].x + y2[i].y; }
        const float mean = wave_sum(s) * (1.f / DM); float s2 = 0.f;
#pragma unroll
        for (int i = 0; i < 8; ++i) { y2[i] -= mean; s2 += y2[i].x * y2[i].x + y2[i].y * y2[i].y; }
        const float rstd = 1.0f / sqrtf(wave_sum(s2) * (1.f / DM) + LN_EPS);
#pragma unroll
        for (int q = 0; q < 4; ++q) { const int col = 16 * lane + 4 * q; const f32x4 gv = *(const f32x4*)(g2 + col), bv = *(const f32x4*)(b2 + col);
            f32x4 o; o[0] = y2[2 * q].x * rstd * gv[0] + bv[0]; o[1] = y2[2 * q].y * rstd * gv[1] + bv[1]; o[2] = y2[2 * q + 1].x * rstd * gv[2] + bv[2]; o[3] = y2[2 * q + 1].y * rstd * gv[3] + bv[3];
            *(f32x4*)(a.out + (size_t)t * DM + col) = o; }
    }
}

#endif

constexpr int NPHASES = 10 + TABLE_FP4;
__global__ void __launch_bounds__(NTHREADS, 2) hymba_fwd(Args args) {
    extern __shared__ __attribute__((aligned(16))) unsigned char lds_raw[];
    LAS unsigned char* lds = (LAS unsigned char*)lds_raw;
    const int tid = threadIdx.x, lane = tid & 63, wave = __builtin_amdgcn_readfirstlane(tid >> 6);
    const int G = gridDim.x; const int bx = blockIdx.x; const int vcu = (G % 8 == 0) ? (bx % 8) * (G / 8) + bx / 8 : bx;
    unsigned char* ws = args.ws;
    const int lo = args.ph_lo, hi = args.ph_hi;
#if ONE_LAUNCH
    volatile LAS unsigned* misc = (volatile LAS unsigned*)(lds + MISC_OFF);
    if (tid < 16) misc[tid] = 0u;
    __syncthreads();
    const XcdBarrier xbar = xcd_barrier_post((unsigned*)(ws + WS_CTL) + 4096, misc);
#define XCD_SYNC() xcd_barrier(xbar)
#else
#define XCD_SYNC() do {} while (0)
#endif
#define IN(k) (lo <= (k) && (k) < hi)
#ifdef REP
#define REPS(k) ((k) == REP ? 2 : 1)
#else
#define REPS(k) 1
#endif
#ifdef ONLY
#define PH_ON(k) ((k) == ONLY)
#else
#define PH_ON(k) true
#endif
#define SEAM(k) do { if (IN(k) && IN((k) + 1)) { XCD_SYNC(); } } while (0)
    if (hi > 1000) { GRID_SYNC(); }
    if (PH_ON(0) && IN(0)) for (int rep_ = 0; rep_ < REPS(0); ++rep_) { phase0(args, lds, vcu, G, wave, lane); } SEAM(0);
    if (PH_ON(1) && IN(1)) for (int rep_ = 0; rep_ < REPS(1); ++rep_) { pg8::Gemm g{(const bf16*)(ws + WS_H0), (const bf16*)(ws + WS_WIN), T, D_IN, DM}; pg8::StaticOrder S; S.init(T, D_IN, G, bx);
        EpiIn E{(bf16*)(ws + WS_XR), (bf16*)(ws + WS_GATE), (bf16*)(ws + WS_MIX), (bf16*)(ws + WS_CCX)};
        pg8::gemm_phase<EpiIn, pg8::StaticOrder, true, true>(lds, g, S, E); } SEAM(1);
    if (PH_ON(2) && IN(2)) { for (int rep = 0; rep < REPS(2); ++rep) phase2(args, lds, vcu, G, tid, wave, lane); } SEAM(2);
    if (PH_ON(3) && IN(3)) for (int rep_ = 0; rep_ < REPS(3); ++rep_) { phase2b(args, vcu, G, tid); } SEAM(3);
    if (PH_ON(4) && IN(4)) for (int rep_ = 0; rep_ < REPS(4); ++rep_) { phase3(args, vcu, G, wave, lane, rep_ == REPS(4) - 1); } SEAM(4);
    if (PH_ON(5) && IN(5)) for (int rep_ = 0; rep_ < REPS(5); ++rep_) { pg8::Gemm g{(const bf16*)(ws + WS_MIX), (const bf16*)(ws + WS_WOUT), T, DM, D_MIX}; pg8::StaticOrder S; S.init(T, DM, G, bx);
        EpiPre E{(const bf16*)(ws + WS_H0), (bf16*)(ws + WS_PRE1)};
        pg8::gemm_phase<EpiPre, pg8::StaticOrder, true, true>(lds, g, S, E); } SEAM(5);
    if (PH_ON(6) && IN(6)) for (int rep_ = 0; rep_ < REPS(6); ++rep_) { phase5(args, vcu, G, tid, wave, lane); } SEAM(6);
    if (PH_ON(7) && IN(7)) for (int rep_ = 0; rep_ < REPS(7); ++rep_) { pg8::Gemm g{(const bf16*)(ws + WS_H1), (const bf16*)(ws + WS_WQ), T, D_Q, DM}; pg8::StaticOrder S; S.init(T, D_Q, G, bx);
        pg8::EpiBf16<0> E{(bf16*)(ws + WS_Q), D_Q, nullptr, 0, 0, 1.f};
        pg8::gemm_phase<pg8::EpiBf16<0>, pg8::StaticOrder, true, true>(lds, g, S, E); } SEAM(7);
    if (PH_ON(8) && IN(8)) { for (int rep = 0; rep < REPS(8); ++rep) phase7(args, lds, vcu, G, tid, wave, lane); } SEAM(8);
#if TABLE_FP4
    if (PH_ON(9) && IN(9)) { for (int rep = 0; rep < REPS(9); ++rep) phase8a(args, vcu, G, wave, lane); }
    if (PH_ON(10) && IN(10)) { for (int rep = 0; rep < REPS(10); ++rep) phase8b(args, vcu, G, wave, lane); }
#else
    if (PH_ON(9) && IN(9)) { for (int rep = 0; rep < REPS(9); ++rep) phase8(args, vcu, G, wave, lane); }
#endif
#undef IN
#undef SEAM
}

extern "C" void kernel_launch(void* const* d_in, const int* in_sizes, int n_in, void* d_out, int out_size, void* d_ws, size_t ws_size, hipStream_t stream) {
    static int grid = 0;
    if (grid == 0) {
        if (n_in != 24 || out_size != T * DM || ws_size < WS_END) { fprintf(stderr, "kernel_launch: unexpected shapes n_in %d out %d ws %zu\n", n_in, out_size, ws_size); grid = -1; return; }
        int dev = 0, cus = 0, per_cu = 0;
        (void)hipGetDevice(&dev); (void)hipDeviceGetAttribute(&cus, hipDeviceAttributeMultiprocessorCount, dev);
        if (hipFuncSetAttribute((const void*)hymba_fwd, hipFuncAttributeMaxDynamicSharedMemorySize, LDS_BYTES) != hipSuccess) { fprintf(stderr, "hipFuncSetAttribute failed\n"); grid = -1; return; }
        (void)hipOccupancyMaxActiveBlocksPerMultiprocessor(&per_cu, (const void*)hymba_fwd, NTHREADS, LDS_BYTES);
        (void)hipGetLastError();
        if (per_cu < 1) { fprintf(stderr, "occupancy query says %d blocks per CU\n", per_cu); grid = -1; return; }
        grid = cus;
    }
    if (grid < 0) return;
    Args a{};
    for (int i = 0; i < 24; ++i) a.in[i] = (const float*)d_in[i];
    a.out = (float*)d_out; a.ws = (unsigned char*)d_ws;
#if ONE_LAUNCH
    (void)hipMemsetAsync((char*)d_ws + WS_CTL, 0, CTL_ZERO_BYTES, stream);
    a.ph_lo = 0; a.ph_hi = NPHASES;
    void* kargs[] = {&a};
    hipError_t e = hipLaunchCooperativeKernel((const void*)hymba_fwd, dim3(grid), dim3(NTHREADS), kargs, LDS_BYTES, stream);
    if (e != hipSuccess) fprintf(stderr, "cooperative launch failed: %s (grid %d)\n", hipGetErrorString(e), grid);
#else
    for (int p = 0; p < NPHASES; ++p) { a.ph_lo = p; a.ph_hi = p + 1; hipLaunchKernelGGL(hymba_fwd, dim3(grid), dim3(NTHREADS), LDS_BYTES, stream, a); }
#endif
}
```
